# Optimizing an MI355X kernel written in HIP

```python
import math
import jax, jax.numpy as jnp
from jax import lax
import numpy as np

D_MODEL = 2048
BATCH = 8
SEQ = 2048
DEPTH = 1

CONV_DIM = 1024
CONV_WIDTH = 3
DIL_PATTERNS = ((128, 1), (512, 4), (2048, 16))
N_DIL_GROUPS = 3
HEADS_PER_GROUP = 4
HEAD_DIM = 128
DIL_DIM = N_DIL_GROUPS * HEADS_PER_GROUP * HEAD_DIM
DIL_OUT_DIM = HEADS_PER_GROUP * HEAD_DIM
ATT_BLOCK = 128
ALIBI_MAX = 8.0
MEM_LEN = 256
MEM_HEADS = 4
MEM_HEAD_DIM = 256
MEM_DIM = MEM_HEADS * MEM_HEAD_DIM
N_BRANCHES = 3
IN_DIM = 3 * CONV_DIM + 3 * DIL_DIM + MEM_DIM + N_BRANCHES * D_MODEL
N_GROUPS = 4
EXPERTS_PER_GROUP = 8
TOP_K = 2
D_EXPERT = 512
ALPHA = (2 * DEPTH) ** 0.25
BETA = (8 * DEPTH) ** -0.25
LN_EPS = 1e-5

kernel_name = "hybrid_conv_dilattn_mem_hmoe_deepnorm"


def _in_splits():
    sizes = [CONV_DIM, CONV_DIM, CONV_DIM, DIL_DIM, DIL_DIM, DIL_DIM, MEM_DIM, N_BRANCHES * D_MODEL]
    out, acc = [], 0
    for s in sizes[:-1]:
        acc += s
        out.append(acc)
    return out


def _alibi_slopes():
    n = N_DIL_GROUPS * HEADS_PER_GROUP
    s = 2.0 ** (-ALIBI_MAX * np.arange(1, n + 1, dtype=np.float32) / n)
    return jnp.asarray(s.reshape(N_DIL_GROUPS, HEADS_PER_GROUP), dtype=jnp.float32)


def layer_norm(x, g, b):
    xf = x.astype(jnp.float32)
    mu = jnp.mean(xf, -1, keepdims=True)
    var = jnp.mean(jnp.square(xf - mu), -1, keepdims=True)
    y = (xf - mu) * lax.rsqrt(var + LN_EPS) * g.astype(jnp.float32) + b.astype(jnp.float32)
    return y.astype(x.dtype)


def short_conv(bg, cg, h, w_conv):
    u = cg * h
    S = u.shape[1]
    up = jnp.pad(u, ((0, 0), (CONV_WIDTH - 1, 0), (0, 0)))
    y = w_conv[0] * up[:, 0:S]
    for j in range(1, CONV_WIDTH):
        y = y + w_conv[j] * up[:, j:j + S]
    return bg * y


def dilated_group_attention(q, k, v, slopes, window, dilation):
    B, S, H, Dh = q.shape
    n_back = window // dilation
    L = S // dilation
    nb = -(-L // ATT_BLOCK)
    Lp = nb * ATT_BLOCK

    def to_sub(t, front):
        t = jnp.swapaxes(t.reshape(B, L, dilation, H, Dh), 1, 2)
        return jnp.pad(t, ((0, 0), (0, 0), (front, Lp - L), (0, 0), (0, 0)))

    def ctx(t):
        tb = to_sub(t, ATT_BLOCK).reshape(B, dilation, nb + 1, ATT_BLOCK, H, Dh)
        return jnp.concatenate([tb[:, :, :-1], tb[:, :, 1:]], axis=3)

    qb = to_sub(q, 0).reshape(B, dilation, nb, ATT_BLOCK, H, Dh)
    kc, vc = ctx(k), ctx(v)
    s = jnp.einsum('bdnqhe,bdnkhe->bdnhqk', qb, kc,
                   preferred_element_type=jnp.float32) * (Dh ** -0.5)
    qi = jnp.arange(ATT_BLOCK)[:, None] + ATT_BLOCK
    kj = jnp.arange(2 * ATT_BLOCK)[None, :]
    jrel = qi - kj
    kabs = (jnp.arange(nb)[:, None, None] - 1) * ATT_BLOCK + kj[None]
    valid = (jrel >= 0) & (jrel <= n_back) & (kabs >= 0)
    bias = -slopes[:, None, None] * (jrel * dilation).astype(jnp.float32)
    s = jnp.where(valid[None, None, :, None], s + bias[None, None, None], -jnp.inf)
    m = jnp.max(s, -1, keepdims=True)
    p = jnp.exp(s - m)
    den = jnp.sum(p, -1, keepdims=True)
    o = jnp.einsum('bdnhqk,bdnkhe->bdnqhe', p.astype(v.dtype), vc,
                   preferred_element_type=jnp.float32)
    o = o / jnp.swapaxes(den, 3, 4)
    lse = jnp.swapaxes((m + jnp.log(den))[..., 0], 3, 4)

    def from_sub(t):
        t = t.reshape((B, dilation, Lp) + t.shape[4:])[:, :, :L]
        t = jnp.swapaxes(t, 1, 2)
        return t.reshape((B, S) + t.shape[3:])

    return from_sub(o), from_sub(lse)


def dilated_mixture_attention(q, k, v):
    B, S, _ = q.shape
    shp = (B, S, N_DIL_GROUPS, HEADS_PER_GROUP, HEAD_DIM)
    q, k, v = q.reshape(shp), k.reshape(shp), v.reshape(shp)
    slopes = _alibi_slopes()
    outs, lses = [], []
    for g, (window, dilation) in enumerate(DIL_PATTERNS):
        o, l = dilated_group_attention(q[:, :, g], k[:, :, g], v[:, :, g], slopes[g], window, dilation)
        outs.append(o)
        lses.append(l)
    outs = jnp.stack(outs, 0)
    wts = jax.nn.softmax(jnp.stack(lses, 0), axis=0)
    o = jnp.sum(wts[..., None] * outs, axis=0)
    return o.reshape(B, S, DIL_OUT_DIM).astype(q.dtype)


def memory_attention(mq, mk, mv):
    B, S, _ = mq.shape
    q = mq.reshape(B, S, MEM_HEADS, MEM_HEAD_DIM)
    k = mk.reshape(B, -1, MEM_HEADS, MEM_HEAD_DIM)
    v = mv.reshape(B, -1, MEM_HEADS, MEM_HEAD_DIM)
    s = jnp.einsum('bshe,bmhe->bhsm', q, k, preferred_element_type=jnp.float32) * (MEM_HEAD_DIM ** -0.5)
    p = jax.nn.softmax(s, axis=-1)
    o = jnp.einsum('bhsm,bmhe->bshe', p.astype(v.dtype), v)
    return o.reshape(B, S, MEM_DIM)


def hierarchical_moe(h, w_group, b_group, w_router, b_router, w_gate, w_up, w_down):
    glog = (h @ w_group + b_group).astype(jnp.float32)
    gprob = jax.nn.softmax(glog, axis=-1)
    gsel = jnp.argmax(glog, axis=-1)
    gw = jnp.take_along_axis(gprob, gsel[..., None], axis=-1)
    elog_all = jnp.einsum('bsd,gde->bsge', h, w_router) + b_router
    elog = jnp.take_along_axis(elog_all, gsel[..., None, None], axis=2)[:, :, 0].astype(jnp.float32)
    top_v, top_i = lax.top_k(elog, TOP_K)
    top_w = jax.nn.softmax(top_v, axis=-1) * gw
    local = jnp.sum(jax.nn.one_hot(top_i, EXPERTS_PER_GROUP, dtype=jnp.float32) * top_w[..., None], axis=2)
    combine = (jax.nn.one_hot(gsel, N_GROUPS, dtype=jnp.float32)[..., None] * local[:, :, None, :]).astype(h.dtype)
    y = jnp.zeros_like(h)
    for g in range(N_GROUPS):
        a = jnp.einsum('bsd,edf->bsef', h, w_gate[g])
        u = jnp.einsum('bsd,edf->bsef', h, w_up[g])
        hid = jax.nn.silu(a) * u * combine[:, :, g, :, None]
        y = y + jnp.einsum('bsef,efd->bsd', hid, w_down[g])
    return y


def setup_inputs(seed: int = 0) -> dict:
    key = jax.random.key(seed)
    ks = jax.random.split(key, 24)
    f32 = jnp.float32
    D, L = D_MODEL, DEPTH

    def nrm(k, shape, scale):
        return jax.random.normal(k, shape, f32) * scale

    v0 = 3 * CONV_DIM + 2 * DIL_DIM
    col_scale = jnp.ones((IN_DIM,), f32).at[v0:v0 + DIL_DIM].set(BETA)
    mem_col = jnp.ones((2 * MEM_DIM,), f32).at[MEM_DIM:].set(BETA)
    G, E, F = N_GROUPS, EXPERTS_PER_GROUP, D_EXPERT
    return {
        "x": nrm(ks[0], (BATCH, SEQ, D), 1.0),
        "mem": nrm(ks[1], (BATCH, MEM_LEN, D), 1.0),
        "ln_mem_g": 1.0 + nrm(ks[2], (D,), 0.02),
        "ln_mem_b": nrm(ks[3], (D,), 0.02),
        "w_in": nrm(ks[4], (L, D, IN_DIM), D ** -0.5) * col_scale,
        "b_in": nrm(ks[5], (L, IN_DIM), 0.02),
        "w_conv": nrm(ks[6], (L, CONV_WIDTH, CONV_DIM), CONV_WIDTH ** -0.5),
        "w_conv_out": nrm(ks[7], (L, CONV_DIM, D), BETA * CONV_DIM ** -0.5),
        "w_dil_out": nrm(ks[8], (L, DIL_OUT_DIM, D), BETA * DIL_OUT_DIM ** -0.5),
        "w_mem_kv": nrm(ks[9], (L, D, 2 * MEM_DIM), D ** -0.5) * mem_col,
        "w_mem_out": nrm(ks[10], (L, MEM_DIM, D), BETA * MEM_DIM ** -0.5),
        "w_o": nrm(ks[11], (L, D, D), BETA * D ** -0.5),
        "ln1_g": 1.0 + nrm(ks[12], (L, D), 0.02),
        "ln1_b": nrm(ks[13], (L, D), 0.02),
        "w_group": nrm(ks[14], (L, D, G), D ** -0.5),
        "b_group": nrm(ks[15], (L, G), 0.01),
        "w_router": nrm(ks[16], (L, G, D, E), D ** -0.5),
        "b_router": nrm(ks[17], (L, G, E), 0.01),
        "w_gate": nrm(ks[18], (L, G, E, D, F), D ** -0.5),
        "w_up": nrm(ks[19], (L, G, E, D, F), D ** -0.5),
        "w_down": nrm(ks[20], (L, G, E, F, D), BETA * F ** -0.5),
        "ln2_g": 1.0 + nrm(ks[21], (L, D), 0.02),
        "ln2_b": nrm(ks[22], (L, D), 0.02),
    }


def reference(x, mem, ln_mem_g, ln_mem_b, w_in, b_in, w_conv, w_conv_out, w_dil_out,
              w_mem_kv, w_mem_out, w_o, ln1_g, ln1_b, w_group, b_group, w_router, b_router,
              w_gate, w_up, w_down, ln2_g, ln2_b):
    B, S, D = x.shape
    mem_n = layer_norm(mem, ln_mem_g, ln_mem_b)
    splits = _in_splits()
    for l in range(DEPTH):
        proj = x @ w_in[l] + b_in[l]
        cb, cc, ch, q, k, v, mq, gates = jnp.split(proj, splits, axis=-1)
        y_conv = short_conv(cb, cc, ch, w_conv[l]) @ w_conv_out[l]
        y_dil = dilated_mixture_attention(q, k, v) @ w_dil_out[l]
        mk, mv = jnp.split(mem_n @ w_mem_kv[l], 2, axis=-1)
        y_mem = memory_attention(mq, mk, mv) @ w_mem_out[l]
        g = jax.nn.sigmoid(gates).reshape(B, S, N_BRANCHES, D)
        merged = g[:, :, 0] * y_conv + g[:, :, 1] * y_dil + g[:, :, 2] * y_mem
        x = layer_norm(ALPHA * x + merged @ w_o[l], ln1_g[l], ln1_b[l])
        y_moe = hierarchical_moe(x, w_group[l], b_group[l], w_router[l], b_router[l],
                                 w_gate[l], w_up[l], w_down[l])
        x = layer_norm(ALPHA * x + y_moe, ln2_g[l], ln2_b[l])
    return x
```

```cpp
#include <hip/hip_runtime.h>
#include <cstdio>
#include <cstdint>

#ifndef MK_N_LAUNCHES
#define MK_N_LAUNCHES 9
#endif

namespace pg8 {
#define PG8_LAS __attribute__((address_space(3)))
typedef unsigned short bf16_t;
typedef short bf16x8 __attribute__((ext_vector_type(8)));
typedef float f32x4 __attribute__((ext_vector_type(4)));
typedef unsigned u32x4 __attribute__((ext_vector_type(4)));
typedef unsigned u32x2 __attribute__((ext_vector_type(2)));
constexpr int BM = 256, BK = 64, HALF = 128, HTB = HALF * BK * 2, STAGE_BYTES = 8 * HTB, NXCD = 8, WGM = 8;

__host__ __device__ __forceinline__ int lds_byte(int r, int c) { const int st = (r >> 4) * 2 + (c >> 5), rr = r & 15, cc = c & 31, ob = rr * 64 + cc * 2; return st * 1024 + (ob ^ (((ob >> 9) & 1) << 5)); }
__host__ __device__ __forceinline__ void stage_rc(int b, int& R, int& C) { const int st = b / 1024, sb = b % 1024, swz = sb ^ (((sb >> 9) & 1) << 5); R = (st >> 1) * 16 + swz / 64; C = (st & 1) * 32 + (swz % 64) / 2; }
__host__ __device__ __forceinline__ int perm32(int rho) { const int n = rho >> 4, i = rho & 15; return 8 * (i >> 2) + 4 * n + (i & 3); }

struct Unit { int pm, pn, pb, aux, nv; };
struct Gemm { const bf16_t* A; const bf16_t* Bt; int K, lda, ldb; };

struct StaticOrder {
    int nM, nN, nwg, G, c;
    __host__ __device__ void init(int M, int N, int G_, int c_) { nM = M / BM; nN = N / BM; nwg = nM * nN; G = G_; c = c_; }
    __host__ __device__ bool next(int i, Unit& u) const {
        const long L = (long)i * G + c; if (L >= nwg) return false;
        int wgid = (int)L; { const int q = nwg / NXCD, r = nwg % NXCD, xcd = wgid % NXCD, off = wgid / NXCD; wgid = (xcd < r ? xcd * (q + 1) : r * (q + 1) + (xcd - r) * q) + off; }
        const int nig = WGM * nN, gid = wgid / nig, fm = gid * WGM, gsz = (nM - fm) < WGM ? (nM - fm) : WGM;
        u.pm = fm + ((wgid % nig) % gsz); u.pn = (wgid % nig) / gsz; u.pb = u.pn; u.aux = 0; u.nv = 256; return true;
    }
    __device__ __forceinline__ unsigned row_of(const Unit&, int r) const { return (unsigned)r; }
    __device__ __forceinline__ void a_ready(const Unit&) const {}
    __device__ __forceinline__ void done(const Unit&) const {}
};

__device__ __forceinline__ unsigned cvt_pk_bf16(float lo, float hi) { unsigned r; asm volatile("v_cvt_pk_bf16_f32 %0, %1, %2" : "=v"(r) : "v"(lo), "v"(hi)); return r; }

template <class Epi, class Sched, bool ALIGN_EPI, bool GATHER>
__device__ __forceinline__ void gemm_phase(PG8_LAS unsigned char* lds, const Gemm g, const Sched& S, const Epi& E) {
    const int tid = threadIdx.x, wid = __builtin_amdgcn_readfirstlane(tid >> 6), lane = tid & 63, wr = wid >> 2, wc = wid & 3, fr = lane & 15, fq = lane >> 4;
    const int K = g.K, nt = K / BK;
    unsigned voffB[2], cvA0[2], cvA1[2], nvA0[2], nvA1[2]; int RA[2], CA[2];
#pragma unroll
    for (int i = 0; i < 2; ++i) { int R, C; stage_rc(tid * 16 + i * 8192, R, C); const int Rb = Epi::PERM ? ((R & ~31) + perm32(R & 31)) : R;
        RA[i] = R; CA[i] = C; voffB[i] = (unsigned)(Rb * g.ldb + C) * 2u; }
    const size_t kstep = (size_t)(BK * 2);
    const size_t hstepB = (size_t)HALF * g.ldb * 2, tstepB = 2 * hstepB, tstepA = (size_t)BM * g.lda * 2;
    const unsigned ldsw = (unsigned)wid * 1024u;
    const int aoff = lds_byte(wr * 64 + fr, fq * 8), boff = lds_byte(wc * 32 + fr, fq * 8);
#define PG8_SA(b, h) (((b) * 2 + (h)) * HTB)
#define PG8_SB(b, h) ((4 + (b) * 2 + (h)) * HTB)
#define PG8_STAGE(bufoff, gbase, voff) do { _Pragma("unroll") for (int _i = 0; _i < 2; ++_i) \
        __builtin_amdgcn_global_load_lds((const unsigned*)((const char*)(gbase) + (voff)[_i]), (PG8_LAS unsigned*)(lds + (bufoff) + ldsw + _i * 8192), 16, 0, 0); } while (0)
#define PG8_LDA(dst, b, h) do { _Pragma("unroll") for (int m = 0; m < 4; ++m) _Pragma("unroll") for (int k = 0; k < 2; ++k) dst[m][k] = *(const PG8_LAS bf16x8*)(lds + PG8_SA(b, h) + aoff + m * 2048 + k * 1024); } while (0)
#define PG8_LDB(dst, b, h) do { _Pragma("unroll") for (int n = 0; n < 2; ++n) _Pragma("unroll") for (int k = 0; k < 2; ++k) dst[n][k] = *(const PG8_LAS bf16x8*)(lds + PG8_SB(b, h) + boff + n * 2048 + k * 1024); } while (0)
#define PG8_MMA(ai, bj, At, Bt) do { __builtin_amdgcn_s_setprio(1); _Pragma("unroll") for (int m = 0; m < 4; ++m) _Pragma("unroll") for (int n = 0; n < 2; ++n) _Pragma("unroll") for (int k = 0; k < 2; ++k) \
        acc[ai][bj][m][n] = __builtin_amdgcn_mfma_f32_16x16x32_bf16(Bt[n][k], At[m][k], acc[ai][bj][m][n], 0, 0, 0); __builtin_amdgcn_s_setprio(0); } while (0)
#define PG8_WAIT_V(n) asm volatile("s_waitcnt vmcnt(" #n ")" ::: "memory")
#define PG8_WAIT_L(n) asm volatile("s_waitcnt lgkmcnt(" #n ")" ::: "memory")
#define PG8_BAR __builtin_amdgcn_s_barrier()
#define PG8_SCHED __builtin_amdgcn_sched_barrier(0)
#define PG8_ROWS(U, d0, d1) do { if constexpr (GATHER) { const unsigned _r0 = S.row_of(U, RA[0]), _r1 = S.row_of(U, RA[1]), _r2 = S.row_of(U, RA[0] + HALF), _r3 = S.row_of(U, RA[1] + HALF); \
        d0[0] = (_r0 * (unsigned)g.lda + (unsigned)CA[0]) * 2u; d0[1] = (_r1 * (unsigned)g.lda + (unsigned)CA[1]) * 2u; d1[0] = (_r2 * (unsigned)g.lda + (unsigned)CA[0]) * 2u; d1[1] = (_r3 * (unsigned)g.lda + (unsigned)CA[1]) * 2u; } \
      else { _Pragma("unroll") for (int _i = 0; _i < 2; ++_i) { d0[_i] = (unsigned)(RA[_i] * g.lda + CA[_i]) * 2u; d1[_i] = d0[_i] + (unsigned)(HALF * g.lda * 2); } } } while (0)
    Unit cur, nxt; int ui = 0;
    if (!S.next(0, cur)) return;
    f32x4 acc[2][2][4][2];
#pragma unroll
    for (int a = 0; a < 2; ++a)
#pragma unroll
        for (int b = 0; b < 2; ++b)
#pragma unroll
            for (int m = 0; m < 4; ++m)
#pragma unroll
                for (int n = 0; n < 2; ++n) acc[a][b][m][n] = (f32x4){0.f, 0.f, 0.f, 0.f};
    bf16x8 At[4][2], B0[2][2], B1[2][2];
    const char* cA = GATHER ? (const char*)g.A : (const char*)g.A + (size_t)cur.pm * tstepA; const char* cB = (const char*)g.Bt + (size_t)cur.pb * tstepB;
    S.a_ready(cur);
    PG8_ROWS(cur, cvA0, cvA1);
    PG8_STAGE(PG8_SB(0, 0), cB, voffB); PG8_STAGE(PG8_SB(0, 1), cB + hstepB, voffB); PG8_STAGE(PG8_SA(0, 0), cA, cvA0); PG8_STAGE(PG8_SA(0, 1), cA, cvA1);
    if (wr == 1) PG8_BAR;
    PG8_WAIT_V(2); PG8_BAR;
    PG8_STAGE(PG8_SB(1, 0), cB + kstep, voffB); PG8_STAGE(PG8_SA(1, 0), cA + kstep, cvA0); PG8_STAGE(PG8_SB(1, 1), cB + hstepB + kstep, voffB);
    PG8_WAIT_V(6); PG8_BAR;
    for (;;) {
        const bool has_next = S.next(ui + 1, nxt);
        const char* nA = has_next ? (GATHER ? (const char*)g.A : (const char*)g.A + (size_t)nxt.pm * tstepA) : cA; const char* nB = has_next ? (const char*)g.Bt + (size_t)nxt.pb * tstepB : cB;
#pragma unroll
        for (int i = 0; i < 2; ++i) { nvA0[i] = cvA0[i]; nvA1[i] = cvA1[i]; }
        for (int t = 0; t < nt; t += 2) {
            const bool last = (t == nt - 2);
            const char* a1 = cA + (size_t)(t + 1) * kstep;
            const char* a2 = last ? nA : cA + (size_t)(t + 2) * kstep; const char* b2 = last ? nB : cB + (size_t)(t + 2) * kstep;
            const char* a3 = a2 + kstep; const char* b3 = b2 + kstep;
            if (last && has_next) { S.a_ready(nxt); if constexpr (GATHER) { PG8_ROWS(nxt, nvA0, nvA1); } }
            unsigned xA0[2], xA1[2];
#pragma unroll
            for (int i = 0; i < 2; ++i) { xA0[i] = last ? nvA0[i] : cvA0[i]; xA1[i] = last ? nvA1[i] : cvA1[i]; }
            PG8_LDB(B0, 0, 0); PG8_LDB(B1, 0, 1); PG8_SCHED; PG8_LDA(At, 0, 0); PG8_STAGE(PG8_SA(1, 1), a1, cvA1);
            PG8_WAIT_V(8); PG8_WAIT_L(0); PG8_BAR; PG8_MMA(0, 0, At, B0); PG8_MMA(0, 1, At, B1); PG8_BAR; PG8_SCHED;
            PG8_LDA(At, 0, 1); PG8_STAGE(PG8_SB(0, 0), b2, voffB); PG8_STAGE(PG8_SB(0, 1), b2 + hstepB, voffB); PG8_STAGE(PG8_SA(0, 0), a2, xA0);
            PG8_WAIT_V(8); PG8_WAIT_L(0); PG8_BAR; PG8_MMA(1, 0, At, B0); PG8_MMA(1, 1, At, B1); PG8_BAR; PG8_SCHED;
            PG8_LDB(B0, 1, 0); PG8_LDB(B1, 1, 1); PG8_SCHED; PG8_LDA(At, 1, 0); PG8_STAGE(PG8_SA(0, 1), a2, xA1);
            PG8_WAIT_V(8); PG8_WAIT_L(0); PG8_BAR; PG8_MMA(0, 0, At, B0); PG8_MMA(0, 1, At, B1); PG8_BAR; PG8_SCHED;
            PG8_LDA(At, 1, 1); PG8_STAGE(PG8_SB(1, 0), b3, voffB); PG8_STAGE(PG8_SB(1, 1), b3 + hstepB, voffB); PG8_STAGE(PG8_SA(1, 0), a3, xA0);
            PG8_WAIT_V(8); PG8_WAIT_L(0); PG8_BAR; PG8_MMA(1, 0, At, B0); PG8_MMA(1, 1, At, B1); PG8_BAR; PG8_SCHED;
        }
        if constexpr (ALIGN_EPI) { if (wr == 0) PG8_BAR; }
        E(acc, cur, wr, wc, fr, fq); S.done(cur);
        if (!has_next) break;
#pragma unroll
        for (int a = 0; a < 2; ++a)
#pragma unroll
            for (int b = 0; b < 2; ++b)
#pragma unroll
                for (int m = 0; m < 4; ++m)
#pragma unroll
                    for (int n = 0; n < 2; ++n) acc[a][b][m][n] = (f32x4){0.f, 0.f, 0.f, 0.f};
        cur = nxt; cA = nA; cB = nB; ++ui;
#pragma unroll
        for (int i = 0; i < 2; ++i) { cvA0[i] = nvA0[i]; cvA1[i] = nvA1[i]; }
        if constexpr (ALIGN_EPI) { if (wr == 1) PG8_BAR; }
    }
    PG8_WAIT_V(0);
    if constexpr (!ALIGN_EPI) { if (wr == 0) PG8_BAR; }
    PG8_BAR;
#undef PG8_SA
#undef PG8_SB
#undef PG8_STAGE
#undef PG8_LDA
#undef PG8_LDB
#undef PG8_MMA
#undef PG8_WAIT_V
#undef PG8_WAIT_L
#undef PG8_BAR
#undef PG8_SCHED
#undef PG8_ROWS
}
}

constexpr int NWAVES = 8;
constexpr int N_LAUNCHES = MK_N_LAUNCHES;
constexpr int N_PHASES = 9;
constexpr int BATCH = 8, SEQ = 2048, DM = 2048, MTOK = BATCH * SEQ;
constexpr int CONV_DIM = 1024, DIL_DIM = 1536, DIL_OUT = 512, MEM_LEN = 256, MEM_DIM = 1024, IN_DIM = 14848;
constexpr int NA = 8704, NGATE = 6144, KCAT = 2560;
constexpr int PA_CB = 0, PA_CC = 1024, PA_CH = 2048, PA_Q = 3072, PA_K = 4608, PA_V = 6144, PA_MQ = 7680;
constexpr int NEXP = 32, DEXP = 512, HROWS = 40960;
constexpr float LN_EPS = 1e-5f;
constexpr float ALPHA = 1.189207115002721f;

constexpr size_t MiB = 1u << 20;
constexpr size_t WS_CTL = 0, CTL_ZERO_BYTES = 1 * MiB;
constexpr size_t WS_LIST = 1 * MiB, WS_TOKW = 3 * MiB;
constexpr size_t WS_WCAT = 8 * MiB, WS_WKV = 18 * MiB, WS_WO = 26 * MiB, WS_MEMN = 34 * MiB, WS_MKV = 42 * MiB;
constexpr size_t WS_WIN = 50 * MiB, WS_XB = 108 * MiB, WS_PA = 172 * MiB, WS_GATES = 444 * MiB, WS_END = 636 * MiB;
constexpr size_t WS_ACAT = 50 * MiB;
constexpr size_t WS_MACC = 172 * MiB;
constexpr size_t WS_MERGED = 300 * MiB;
constexpr size_t WS_X1B = 364 * MiB;
constexpr size_t WS_WGU = 444 * MiB;
constexpr size_t WS_WD = 572 * MiB;
constexpr size_t WS_H = 50 * MiB;
constexpr size_t WS_Y = 172 * MiB;
static_assert(WS_WIN + (size_t)IN_DIM * DM * 2 <= WS_XB && WS_XB + (size_t)MTOK * DM * 2 <= WS_PA && WS_PA + (size_t)MTOK * NA * 2 <= WS_GATES && WS_GATES + (size_t)MTOK * NGATE * 2 <= WS_END, "ws map");
static_assert(WS_ACAT + (size_t)MTOK * KCAT * 2 <= WS_PA && WS_MACC + (size_t)MTOK * DM * 4 <= WS_MERGED && WS_MERGED + (size_t)MTOK * DM * 2 <= WS_X1B && WS_X1B + (size_t)MTOK * DM * 2 <= WS_WGU, "ws map 2");
static_assert(WS_WGU + (size_t)NEXP * 1024 * DM * 2 <= WS_WD && WS_WD + (size_t)NEXP * DM * DEXP * 2 <= WS_END && WS_H + (size_t)HROWS * DEXP * 2 <= WS_PA && WS_Y + (size_t)2 * MTOK * DM * 2 <= WS_X1B, "ws map 3");

constexpr int CW_TMO = 0, CW_CODE = 1, CW_BAR = 4096, CW_CNT = 16384;

constexpr int RING_OFF = 0, RING_BYTES = 131072;
constexpr int LDSCTL_OFF = RING_BYTES, MISC_OFF = LDSCTL_OFF + 320, TAB_OFF = LDSCTL_OFF + 1024;
constexpr int LDS_BYTES = 147456;
static_assert(TAB_OFF + 2048 <= LDS_BYTES, "LDS map");

#define GAS __attribute__((address_space(1)))
#define LAS __attribute__((address_space(3)))
typedef unsigned short bf16;
typedef unsigned v4u __attribute__((ext_vector_type(4)));
typedef unsigned v2u __attribute__((ext_vector_type(2)));
typedef float f32x4 __attribute__((ext_vector_type(4)));
typedef GAS unsigned gu32;
#define RLX_AGENT __ATOMIC_RELAXED, __HIP_MEMORY_SCOPE_AGENT
#define LDS_WAIT() asm volatile("s_waitcnt lgkmcnt(0)" ::: "memory")
#define VM_WAIT() asm volatile("s_waitcnt vmcnt(0)" ::: "memory")
__device__ __forceinline__ unsigned f2bf(float f) { unsigned u = __builtin_bit_cast(unsigned, f); return (u + 0x7fffu + ((u >> 16) & 1u)) >> 16; }
__device__ __forceinline__ unsigned pk2(float lo, float hi) { return f2bf(lo) | (f2bf(hi) << 16); }
__device__ __forceinline__ float bflo(unsigned w) { return __builtin_bit_cast(float, w << 16); }
__device__ __forceinline__ float bfhi(unsigned w) { return __builtin_bit_cast(float, w & 0xffff0000u); }
__device__ __forceinline__ float bf1(bf16 b) { return __builtin_bit_cast(float, (unsigned)b << 16); }

#define XB_TMO      128
#define XB_XCNT(j)  (256  + 64 * (j))
#define XB_XSUB(j)  (1280 + 64 * (j))
#define XB_XGEN(j)  (2304 + 64 * (j))
#define XB_TOP      3328
#define XB_TOPGEN   3392
#define XCD_BAR_WORDS 3456
#define XB_SPIN_CAP (1u << 18)
__device__ __forceinline__ unsigned xb_ld(unsigned* p)              { return __hip_atomic_load(p, __ATOMIC_RELAXED, __HIP_MEMORY_SCOPE_AGENT); }
__device__ __forceinline__ unsigned xb_add(unsigned* p, unsigned v) { return __hip_atomic_fetch_add(p, v, __ATOMIC_RELAXED, __HIP_MEMORY_SCOPE_AGENT); }
__device__ __forceinline__ unsigned xb_xcc_id() { return (unsigned)__builtin_amdgcn_s_getreg((3 << 11) | 20) & 0xFu; }
#define XB_SPIN(cond, bar) do { unsigned _sp = 0; while (cond) { __builtin_amdgcn_s_sleep(1); \
    if ((++_sp & 255u) == 0u) { if (xb_ld(&(bar)[XB_TMO])) break; if (_sp > XB_SPIN_CAP) { atomicAdd(&(bar)[XB_TMO], 1u); break; } } } } while (0)
struct XcdBarrier { unsigned* bar; unsigned x; volatile LAS unsigned* st; };
__device__ __forceinline__ XcdBarrier xcd_barrier_post(unsigned* bar, volatile LAS unsigned* st) {
    XcdBarrier b; b.bar = bar; b.x = xb_xcc_id(); b.st = st;
    if (threadIdx.x == 0) (void)xb_add(&bar[XB_XCNT(b.x)], 1u);
    return b;
}
__device__ __forceinline__ void xcd_barrier_complete(unsigned* bar, unsigned x, unsigned& nloc, unsigned& nx) {
    const unsigned G = gridDim.x * gridDim.y * gridDim.z;
    unsigned sum, cnt, mine, sp = 0u;
    for (;;) {
        sum = 0u; cnt = 0u; mine = 0u;
#pragma unroll
        for (unsigned j = 0; j < 16; ++j) { const unsigned c = xb_ld(&bar[XB_XCNT(j)]); sum += c; cnt += (c > 0u) ? 1u : 0u; mine = (j == x) ? c : mine; }
        if (sum == G) break;
        __builtin_amdgcn_s_sleep(1);
        if ((++sp & 255u) == 0u) { if (xb_ld(&bar[XB_TMO])) break; if (sp > XB_SPIN_CAP) { atomicAdd(&bar[XB_TMO], 1u); break; } }
    }
    nloc = mine > 0u ? mine : 1u; nx = cnt > 0u ? cnt : 1u;
}
__device__ __forceinline__ void xcd_barrier(const XcdBarrier& b) {
    asm volatile("s_waitcnt vmcnt(0)" ::: "memory");
    __syncthreads();
    if (threadIdx.x == 0) {
        unsigned* bar = b.bar;
        __builtin_amdgcn_s_waitcnt(0);
        unsigned nloc = b.st[0], nx = b.st[1];
        if (nloc == 0u) { xcd_barrier_complete(bar, b.x, nloc, nx); b.st[0] = nloc; b.st[1] = nx; }
        const unsigned old = xb_add(&bar[XB_XSUB(b.x)], 1u);
        const unsigned gen = old / nloc;
        if (old + 1u == (gen + 1u) * nloc) {
            __builtin_amdgcn_fence(__ATOMIC_RELEASE, "agent");
            asm volatile("s_waitcnt vmcnt(0)" ::: "memory");
            const unsigned og = xb_add(&bar[XB_TOP], 1u);
            const unsigned tg = og / nx;
            if (og + 1u == (tg + 1u) * nx) xb_add(&bar[XB_TOPGEN], 1u);
            else XB_SPIN(xb_ld(&bar[XB_TOPGEN]) == tg, bar);
            __builtin_amdgcn_fence(__ATOMIC_ACQUIRE, "agent");
            xb_add(&bar[XB_XGEN(b.x)], 1u);
            asm volatile("s_waitcnt vmcnt(0)" ::: "memory");
        } else {
            XB_SPIN(xb_ld(&bar[XB_XGEN(b.x)]) == gen, bar);
            __builtin_amdgcn_fence(__ATOMIC_ACQUIRE, "agent");
            asm volatile("s_waitcnt vmcnt(0)" ::: "memory");
        }
    }
    __syncthreads();
}

struct Frame {
    LAS unsigned char* lds;
    volatile LAS unsigned* MISC;
    gu32* ctl;
    int tid, lane, wave;
    int vcu, G;
    unsigned char* ws;
    const float* in[23];
    float* out;
};

__device__ __forceinline__ float wave_sum(float v) {
#pragma unroll
    for (int o = 1; o < 64; o <<= 1) v += __shfl_xor(v, o);
    return v;
}
__device__ __forceinline__ float wave_max(float v) {
#pragma unroll
    for (int o = 1; o < 64; o <<= 1) v = fmaxf(v, __shfl_xor(v, o));
    return v;
}

__device__ __forceinline__ void transpose_item(const float* W, int N, bf16* WT, int ldt, size_t drow0, int dcol0, int k0, int n0, LAS float* scr, int lane) {
#pragma unroll 8
    for (int i = 0; i < 32; ++i) { const int kk = 2 * i + (lane >> 5); scr[kk * 33 + (lane & 31)] = W[(size_t)(k0 + kk) * N + n0 + (lane & 31)]; }
    LDS_WAIT(); asm volatile("" ::: "memory");
    const int c = lane & 7;
#pragma unroll
    for (int j = 0; j < 4; ++j) { const int n = (lane >> 3) + 8 * j; const LAS float* s = scr + (8 * c) * 33 + n;
        v4u o; o.x = pk2(s[0 * 33], s[1 * 33]); o.y = pk2(s[2 * 33], s[3 * 33]); o.z = pk2(s[4 * 33], s[5 * 33]); o.w = pk2(s[6 * 33], s[7 * 33]);
        *(GAS v4u*)(WT + (drow0 + n) * ldt + dcol0 + 8 * c) = o; }
    LDS_WAIT(); asm volatile("" ::: "memory");
}
__device__ __forceinline__ void transpose_matrix(Frame& F, LAS float* scr, const float* W, int K, int N, bf16* WT, int ldt, int dcol_base, int gw, int NGW) {
    const int nblk = N / 32, nitems = (K / 64) * nblk;
    for (int it = gw; it < nitems; it += NGW) { const int kb = it / nblk, nb = it % nblk; transpose_item(W, N, WT, ldt, (size_t)(32 * nb), dcol_base + 64 * kb, 64 * kb, 32 * nb, scr, F.lane); }
}

__device__ __forceinline__ void p0_prologue(Frame& F) {
    LAS float* scr = (LAS float*)(F.lds + RING_OFF + F.wave * 16384);
    const int gw = F.vcu * NWAVES + F.wave, NGW = F.G * NWAVES;
    unsigned char* ws = F.ws;
    transpose_matrix(F, scr, F.in[4], DM, IN_DIM, (bf16*)(ws + WS_WIN), DM, 0, gw, NGW);
    transpose_matrix(F, scr, F.in[7], CONV_DIM, DM, (bf16*)(ws + WS_WCAT), KCAT, 0, gw, NGW);
    transpose_matrix(F, scr, F.in[8], DIL_OUT, DM, (bf16*)(ws + WS_WCAT), KCAT, 1024, gw, NGW);
    transpose_matrix(F, scr, F.in[10], MEM_DIM, DM, (bf16*)(ws + WS_WCAT), KCAT, 1536, gw, NGW);
    transpose_matrix(F, scr, F.in[9], DM, 2 * MEM_DIM, (bf16*)(ws + WS_WKV), DM, 0, gw, NGW);
    transpose_matrix(F, scr, F.in[11], DM, DM, (bf16*)(ws + WS_WO), DM, 0, gw, NGW);
    { const GAS f32x4* x4 = (const GAS f32x4*)F.in[0]; GAS v4u* o4 = (GAS v4u*)(ws + WS_XB); const size_t n8 = (size_t)MTOK * DM / 8;
      for (size_t i = (size_t)gw * 64 + F.lane; i < n8; i += (size_t)NGW * 64) { const f32x4 a = x4[2 * i], b = x4[2 * i + 1]; v4u o; o.x = pk2(a.x, a.y); o.y = pk2(a.z, a.w); o.z = pk2(b.x, b.y); o.w = pk2(b.z, b.w); o4[i] = o; } }
    { const float* gm = F.in[2]; const float* bm = F.in[3]; bf16* mo = (bf16*)(ws + WS_MEMN);
      for (int m = gw; m < BATCH * MEM_LEN; m += NGW) {
        const GAS f32x4* xr = (const GAS f32x4*)(F.in[1] + (size_t)m * DM) + F.lane; f32x4 v[8]; float s = 0.f;
#pragma unroll
        for (int j = 0; j < 8; ++j) { v[j] = xr[64 * j]; s += (v[j].x + v[j].y) + (v[j].z + v[j].w); }
        const float mean = wave_sum(s) * (1.f / DM); float s2 = 0.f;
#pragma unroll
        for (int j = 0; j < 8; ++j) { v[j] = v[j] - mean; s2 += (v[j].x * v[j].x + v[j].y * v[j].y) + (v[j].z * v[j].z + v[j].w * v[j].w); }
        const float rstd = 1.f / sqrtf(wave_sum(s2) * (1.f / DM) + LN_EPS);
        GAS v2u* o8 = (GAS v2u*)(mo + (size_t)m * DM) + F.lane;
#pragma unroll
        for (int j = 0; j < 8; ++j) { const f32x4 gg = ((const GAS f32x4*)gm)[F.lane + 64 * j], bb = ((const GAS f32x4*)bm)[F.lane + 64 * j]; const f32x4 y = v[j] * rstd * gg + bb;
            v2u o; o.x = pk2(y.x, y.y); o.y = pk2(y.z, y.w); o8[64 * j] = o; }
      } }
}

using pg8::Unit; using pg8::cvt_pk_bf16; using pg8::HALF; using pg8::BM;
struct EpiProj {
    static constexpr bool PERM = true;
    bf16* PA; bf16* GT; const float* bias;
    __device__ __forceinline__ void operator()(const f32x4 (&acc)[2][2][4][2], const Unit& u, int wr, int wc, int fr, int fq) const {
        const int row0 = u.pm * BM + wr * 64 + fr; const bool isg = u.pn >= NA / 256;
        bf16* base = isg ? GT : PA; const int ldc = isg ? NGATE : NA; const int colt = isg ? (u.pn - NA / 256) * BM : u.pn * BM;
        const int col0 = colt + wc * 32 + 8 * fq, bcol0 = u.pn * BM + wc * 32 + 8 * fq;
        f32x4 bv[2][2];
#pragma unroll
        for (int bj = 0; bj < 2; ++bj)
#pragma unroll
            for (int n = 0; n < 2; ++n) bv[bj][n] = *(const f32x4*)(bias + bcol0 + bj * HALF + 4 * n);
#pragma unroll
        for (int ai = 0; ai < 2; ++ai)
#pragma unroll
            for (int m = 0; m < 4; ++m) { bf16* rowp = base + (size_t)(row0 + ai * HALF + m * 16) * ldc + col0;
#pragma unroll
                for (int bj = 0; bj < 2; ++bj) { f32x4 v0 = acc[ai][bj][m][0] + bv[bj][0], v1 = acc[ai][bj][m][1] + bv[bj][1];
                    if (isg) {
#pragma unroll
                        for (int j = 0; j < 4; ++j) { v0[j] = __builtin_amdgcn_rcpf(1.f + __builtin_amdgcn_exp2f(-1.4426950408889634f * v0[j])); v1[j] = __builtin_amdgcn_rcpf(1.f + __builtin_amdgcn_exp2f(-1.4426950408889634f * v1[j])); } }
                    pg8::u32x4 w; w.x = cvt_pk_bf16(v0[0], v0[1]); w.y = cvt_pk_bf16(v0[2], v0[3]); w.z = cvt_pk_bf16(v1[0], v1[1]); w.w = cvt_pk_bf16(v1[2], v1[3]);
                    *(pg8::u32x4*)(rowp + bj * HALF) = w; } }
    }
};
struct EpiPlain {
    static constexpr bool PERM = true;
    bf16* O; int ldc;
    __device__ __forceinline__ void operator()(const f32x4 (&acc)[2][2][4][2], const Unit& u, int wr, int wc, int fr, int fq) const {
        const int row0 = u.pm * BM + wr * 64 + fr, col0 = u.pn * BM + wc * 32 + 8 * fq;
#pragma unroll
        for (int ai = 0; ai < 2; ++ai)
#pragma unroll
            for (int m = 0; m < 4; ++m) { bf16* rowp = O + (size_t)(row0 + ai * HALF + m * 16) * ldc + col0;
#pragma unroll
                for (int bj = 0; bj < 2; ++bj) { const f32x4 v0 = acc[ai][bj][m][0], v1 = acc[ai][bj][m][1];
                    pg8::u32x4 w; w.x = cvt_pk_bf16(v0[0], v0[1]); w.y = cvt_pk_bf16(v0[2], v0[3]); w.z = cvt_pk_bf16(v1[0], v1[1]); w.w = cvt_pk_bf16(v1[2], v1[3]);
                    *(pg8::u32x4*)(rowp + bj * HALF) = w; } }
    }
};
template <int MODE> struct EpiMerge {
    static constexpr bool PERM = false;
    const bf16* GT; float* macc; bf16* merged;
    __device__ __forceinline__ void operator()(const f32x4 (&acc)[2][2][4][2], const Unit& u, int wr, int wc, int fr, int fq) const {
        const int row0 = u.pm * BM + wr * 64 + fr, col0 = u.pn * BM + wc * 32 + 4 * fq;
#pragma unroll
        for (int ai = 0; ai < 2; ++ai)
#pragma unroll
            for (int m = 0; m < 4; ++m) { const size_t row = (size_t)(row0 + ai * HALF + m * 16);
#pragma unroll
                for (int bj = 0; bj < 2; ++bj)
#pragma unroll
                    for (int n = 0; n < 2; ++n) { const int col = col0 + bj * HALF + n * 16;
                        const v2u gw = *(const v2u*)(GT + row * NGATE + MODE * DM + col);
                        f32x4 gv; gv.x = bflo(gw.x); gv.y = bfhi(gw.x); gv.z = bflo(gw.y); gv.w = bfhi(gw.y);
                        f32x4 r = gv * acc[ai][bj][m][n];
                        if (MODE > 0) r += *(const f32x4*)(macc + row * DM + col);
                        if (MODE < 2) *(f32x4*)(macc + row * DM + col) = r;
                        else { v2u o; o.x = cvt_pk_bf16(r.x, r.y); o.y = cvt_pk_bf16(r.z, r.w); *(v2u*)(merged + row * DM + col) = o; } } }
    }
};
struct EpiWo {
    static constexpr bool PERM = false;
    const float* x; float* y;
    __device__ __forceinline__ void operator()(const f32x4 (&acc)[2][2][4][2], const Unit& u, int wr, int wc, int fr, int fq) const {
        const int row0 = u.pm * BM + wr * 64 + fr, col0 = u.pn * BM + wc * 32 + 4 * fq;
#pragma unroll
        for (int ai = 0; ai < 2; ++ai)
#pragma unroll
            for (int m = 0; m < 4; ++m) { const size_t off = (size_t)(row0 + ai * HALF + m * 16) * DM + col0;
#pragma unroll
                for (int bj = 0; bj < 2; ++bj)
#pragma unroll
                    for (int n = 0; n < 2; ++n) { const f32x4 xv = *(const f32x4*)(x + off + bj * HALF + n * 16); *(f32x4*)(y + off + bj * HALF + n * 16) = xv * ALPHA + acc[ai][bj][m][n]; } }
    }
};
struct EpiGateUp {
    static constexpr bool PERM = true;
    bf16* H;
    __device__ __forceinline__ void operator()(const f32x4 (&acc)[2][2][4][2], const Unit& u, int wr, int wc, int fr, int fq) const {
        const int row0 = u.pm * BM + wr * 64 + fr, col0 = u.pn * HALF + wc * 32 + 8 * fq;
#pragma unroll
        for (int ai = 0; ai < 2; ++ai)
#pragma unroll
            for (int m = 0; m < 4; ++m) { bf16* rowp = H + (size_t)(row0 + ai * HALF + m * 16) * DEXP + col0;
                f32x4 h0, h1;
#pragma unroll
                for (int j = 0; j < 4; ++j) { const float a0 = acc[ai][0][m][0][j], a1 = acc[ai][0][m][1][j];
                    h0[j] = a0 * __builtin_amdgcn_rcpf(1.f + __builtin_amdgcn_exp2f(-1.4426950408889634f * a0)) * acc[ai][1][m][0][j];
                    h1[j] = a1 * __builtin_amdgcn_rcpf(1.f + __builtin_amdgcn_exp2f(-1.4426950408889634f * a1)) * acc[ai][1][m][1][j]; }
                pg8::u32x4 w; w.x = cvt_pk_bf16(h0[0], h0[1]); w.y = cvt_pk_bf16(h0[2], h0[3]); w.z = cvt_pk_bf16(h1[0], h1[1]); w.w = cvt_pk_bf16(h1[2], h1[3]);
                *(pg8::u32x4*)rowp = w; }
    }
};
struct EpiDown {
    static constexpr bool PERM = true;
    bf16* Y; const unsigned* list;
    __device__ __forceinline__ void operator()(const f32x4 (&acc)[2][2][4][2], const Unit& u, int wr, int wc, int fr, int fq) const {
        const int r0 = wr * 64 + fr, col0 = u.pn * BM + wc * 32 + 8 * fq;
#pragma unroll
        for (int ai = 0; ai < 2; ++ai)
#pragma unroll
            for (int m = 0; m < 4; ++m) { const int r = r0 + ai * HALF + m * 16;
                if (r < u.nv) { const unsigned li = list[u.aux + r]; const unsigned tok = li >> 1, k = li & 1u;
                    bf16* rowp = Y + ((size_t)k * MTOK + tok) * DM + col0;
#pragma unroll
                    for (int bj = 0; bj < 2; ++bj) { const f32x4 v0 = acc[ai][bj][m][0], v1 = acc[ai][bj][m][1];
                        pg8::u32x4 w; w.x = cvt_pk_bf16(v0[0], v0[1]); w.y = cvt_pk_bf16(v0[2], v0[3]); w.z = cvt_pk_bf16(v1[0], v1[1]); w.w = cvt_pk_bf16(v1[2], v1[3]);
                        *(pg8::u32x4*)(rowp + bj * HALF) = w; } } }
    }
};

struct MoeOrder {
    const LAS int* tab; const unsigned* list; int NT, G, c;
    __device__ __forceinline__ bool next(int i, Unit& u) const {
        const int T = __builtin_amdgcn_readfirstlane(tab[0]); const int L = i * G + c; if (L >= T * NT) return false;
        const int tile = L / NT, pn = L % NT; const int e = __builtin_amdgcn_readfirstlane(tab[64 + tile]); const int mt = tile - __builtin_amdgcn_readfirstlane(tab[1 + e]);
        u.pm = tile; u.pn = pn; u.pb = e * NT + pn; u.aux = e * MTOK + 256 * mt; u.nv = __builtin_amdgcn_readfirstlane(tab[256 + e]) - 256 * mt; return true;
    }
    __device__ __forceinline__ unsigned row_of(const Unit& u, int r) const { const int rr = r < u.nv ? r : u.nv - 1; return list[u.aux + rr] >> 1; }
    __device__ __forceinline__ void a_ready(const Unit&) const {}
    __device__ __forceinline__ void done(const Unit&) const {}
};
__device__ __forceinline__ void moe_plan(Frame& F) {
    LAS int* tab = (LAS int*)(F.lds + TAB_OFF);
    if (F.tid < NEXP) { int c = (int)__hip_atomic_load(F.ctl + CW_CNT + 64 * F.tid, RLX_AGENT); if (c > MTOK) c = MTOK; if (c < 0) c = 0; tab[256 + F.tid] = c; tab[320 + F.tid] = (c + 255) >> 8; }
    __syncthreads();
    if (F.tid == 0) { int s = 0; for (int e = 0; e < NEXP; ++e) { tab[1 + e] = s; s += tab[320 + e]; } if (s > HROWS / 256) s = HROWS / 256; tab[0] = s; }
    __syncthreads();
    if (F.tid < HROWS / 256) { int e = 0; for (int q = 0; q < NEXP; ++q) { if (F.tid >= tab[1 + q] && F.tid < tab[1 + q] + tab[320 + q]) e = q; } tab[64 + F.tid] = e; }
    __syncthreads();
}

__device__ __forceinline__ void p2_mixers(Frame& F) {
    const int gw = F.vcu * NWAVES + F.wave, NGW = F.G * NWAVES, lane = F.lane;
    const bf16* PA = (const bf16*)(F.ws + WS_PA); const bf16* MKV = (const bf16*)(F.ws + WS_MKV); bf16* AC = (bf16*)(F.ws + WS_ACAT);
    LAS float* pb = (LAS float*)(F.lds + RING_OFF + F.wave * 16384);
    { const float* wc = F.in[6];
      const size_t nitem = (size_t)MTOK * (CONV_DIM / 8);
      for (size_t it = (size_t)gw * 64 + lane; it < nitem; it += (size_t)NGW * 64) {
        const int tok = (int)(it / (CONV_DIM / 8)), c8 = (int)(it % (CONV_DIM / 8)) * 8, t = tok & (SEQ - 1);
        float accv[8];
#pragma unroll
        for (int j = 0; j < 8; ++j) accv[j] = 0.f;
#pragma unroll
        for (int d = 0; d < 3; ++d) { if (t - (2 - d) >= 0) { const bf16* rowp = PA + (size_t)(tok - (2 - d)) * NA;
            const v4u c4 = *(const v4u*)(rowp + PA_CC + c8), h4 = *(const v4u*)(rowp + PA_CH + c8);
            const unsigned cw[4] = {c4.x, c4.y, c4.z, c4.w}, hw[4] = {h4.x, h4.y, h4.z, h4.w};
#pragma unroll
            for (int q = 0; q < 4; ++q) { accv[2 * q] += wc[d * CONV_DIM + c8 + 2 * q] * (bflo(cw[q]) * bflo(hw[q])); accv[2 * q + 1] += wc[d * CONV_DIM + c8 + 2 * q + 1] * (bfhi(cw[q]) * bfhi(hw[q])); } } }
        const v4u b4 = *(const v4u*)(PA + (size_t)tok * NA + PA_CB + c8); const unsigned bw[4] = {b4.x, b4.y, b4.z, b4.w};
        v4u o; o.x = pk2(bflo(bw[0]) * accv[0], bfhi(bw[0]) * accv[1]); o.y = pk2(bflo(bw[1]) * accv[2], bfhi(bw[1]) * accv[3]); o.z = pk2(bflo(bw[2]) * accv[4], bfhi(bw[2]) * accv[5]); o.w = pk2(bflo(bw[3]) * accv[6], bfhi(bw[3]) * accv[7]);
        *(v4u*)(AC + (size_t)tok * KCAT + c8) = o; } }
    for (int it = gw; it < MTOK * 4; it += NGW) {
        const int tok = it >> 2, h = it & 3, t = tok & (SEQ - 1);
        float sc[7];
#pragma unroll
        for (int i = 0; i < 7; ++i) { const int kk = lane + 64 * i; float s = -INFINITY;
            if (kk < 387) { const int g = kk / 129, j = kk - 129 * g, dil = (g == 0) ? 1 : (g == 1 ? 4 : 16), pos = t - j * dil;
                if (pos >= 0) { const bf16* qp = PA + (size_t)tok * NA + PA_Q + g * 512 + h * 128; const bf16* kp = PA + (size_t)(tok - j * dil) * NA + PA_K + g * 512 + h * 128;
                    float d = 0.f;
#pragma unroll 4
                    for (int c = 0; c < 16; ++c) { const v4u qa = *(const v4u*)(qp + 8 * c), ka = *(const v4u*)(kp + 8 * c);
                        d += bflo(qa.x) * bflo(ka.x) + bfhi(qa.x) * bfhi(ka.x) + bflo(qa.y) * bflo(ka.y) + bfhi(qa.y) * bfhi(ka.y) + bflo(qa.z) * bflo(ka.z) + bfhi(qa.z) * bfhi(ka.z) + bflo(qa.w) * bflo(ka.w) + bfhi(qa.w) * bfhi(ka.w); }
                    const float slope = exp2f(-8.0f * (float)(g * 4 + h + 1) / 12.0f);
                    s = d * 0.08838834764831845f - slope * (float)(j * dil); } }
            sc[i] = s; }
        float mx = sc[0];
#pragma unroll
        for (int i = 1; i < 7; ++i) mx = fmaxf(mx, sc[i]);
        mx = wave_max(mx); float den = 0.f;
#pragma unroll
        for (int i = 0; i < 7; ++i) { sc[i] = (sc[i] == -INFINITY) ? 0.f : __expf(sc[i] - mx); den += sc[i]; }
        den = wave_sum(den); const float inv = 1.f / den;
#pragma unroll
        for (int i = 0; i < 7; ++i) pb[lane + 64 * i] = sc[i] * inv;
        LDS_WAIT(); asm volatile("" ::: "memory");
        float o0 = 0.f, o1 = 0.f;
        for (int g = 0; g < 3; ++g) { const int dil = (g == 0) ? 1 : (g == 1 ? 4 : 16); int jmax = t / dil; if (jmax > 128) jmax = 128;
            const bf16* vp = PA + (size_t)tok * NA + PA_V + g * 512 + h * 128 + 2 * lane;
            for (int j = 0; j <= jmax; ++j) { const float p = pb[129 * g + j]; const unsigned vv = *(const unsigned*)(vp - (size_t)(j * dil) * NA); o0 += p * bflo(vv); o1 += p * bfhi(vv); } }
        *(unsigned*)(AC + (size_t)tok * KCAT + 1024 + h * 128 + 2 * lane) = pk2(o0, o1);
        LDS_WAIT(); asm volatile("" ::: "memory");
    }
    for (int it = gw; it < MTOK * 4; it += NGW) {
        const int tok = it >> 2, h = it & 3, b = tok >> 11;
        const bf16* qp = PA + (size_t)tok * NA + PA_MQ + h * 256;
        float sc[4];
#pragma unroll
        for (int i = 0; i < 4; ++i) { const bf16* kp = MKV + (size_t)(b * MEM_LEN + lane + 64 * i) * (2 * MEM_DIM) + h * 256; float d = 0.f;
#pragma unroll 4
            for (int c = 0; c < 32; ++c) { const v4u qa = *(const v4u*)(qp + 8 * c), ka = *(const v4u*)(kp + 8 * c);
                d += bflo(qa.x) * bflo(ka.x) + bfhi(qa.x) * bfhi(ka.x) + bflo(qa.y) * bflo(ka.y) + bfhi(qa.y) * bfhi(ka.y) + bflo(qa.z) * bflo(ka.z) + bfhi(qa.z) * bfhi(ka.z) + bflo(qa.w) * bflo(ka.w) + bfhi(qa.w) * bfhi(ka.w); }
            sc[i] = d * 0.0625f; }
        float mx = fmaxf(fmaxf(sc[0], sc[1]), fmaxf(sc[2], sc[3])); mx = wave_max(mx); float den = 0.f;
#pragma unroll
        for (int i = 0; i < 4; ++i) { sc[i] = __expf(sc[i] - mx); den += sc[i]; }
        den = wave_sum(den); const float inv = 1.f / den;
#pragma unroll
        for (int i = 0; i < 4; ++i) pb[lane + 64 * i] = sc[i] * inv;
        LDS_WAIT(); asm volatile("" ::: "memory");
        float o[4] = {0.f, 0.f, 0.f, 0.f};
        const bf16* vp = MKV + (size_t)(b * MEM_LEN) * (2 * MEM_DIM) + MEM_DIM + h * 256 + 4 * lane;
        for (int m = 0; m < MEM_LEN; ++m) { const float p = pb[m]; const v2u vv = *(const v2u*)(vp + (size_t)m * (2 * MEM_DIM)); o[0] += p * bflo(vv.x); o[1] += p * bfhi(vv.x); o[2] += p * bflo(vv.y); o[3] += p * bfhi(vv.y); }
        v2u ov; ov.x = pk2(o[0], o[1]); ov.y = pk2(o[2], o[3]);
        *(v2u*)(AC + (size_t)tok * KCAT + 1536 + h * 256 + 4 * lane) = ov;
        LDS_WAIT(); asm volatile("" ::: "memory");
    }
}

__device__ __forceinline__ void p5_ln_route(Frame& F) {
    const int gw = F.vcu * NWAVES + F.wave, NGW = F.G * NWAVES, lane = F.lane;
    float* Y1 = F.out; bf16* X1B = (bf16*)(F.ws + WS_X1B); unsigned* list = (unsigned*)(F.ws + WS_LIST); float* tokw = (float*)(F.ws + WS_TOKW);
    const float* g1 = F.in[12]; const float* b1 = F.in[13]; const float* wg = F.in[14]; const float* bg = F.in[15]; const float* wrt = F.in[16]; const float* brt = F.in[17];
    for (int m = gw; m < MTOK; m += NGW) {
        GAS f32x4* xr = (GAS f32x4*)(Y1 + (size_t)m * DM) + lane; f32x4 v[8]; float s = 0.f;
#pragma unroll
        for (int j = 0; j < 8; ++j) { v[j] = xr[64 * j]; s += (v[j].x + v[j].y) + (v[j].z + v[j].w); }
        const float mean = wave_sum(s) * (1.f / DM); float s2 = 0.f;
#pragma unroll
        for (int j = 0; j < 8; ++j) { v[j] = v[j] - mean; s2 += (v[j].x * v[j].x + v[j].y * v[j].y) + (v[j].z * v[j].z + v[j].w * v[j].w); }
        const float rstd = 1.f / sqrtf(wave_sum(s2) * (1.f / DM) + LN_EPS);
        GAS v2u* o8 = (GAS v2u*)(X1B + (size_t)m * DM) + lane;
        float gl[4] = {0.f, 0.f, 0.f, 0.f};
#pragma unroll
        for (int j = 0; j < 8; ++j) { const f32x4 gg = ((const GAS f32x4*)g1)[lane + 64 * j], bb = ((const GAS f32x4*)b1)[lane + 64 * j]; v[j] = v[j] * rstd * gg + bb;
            xr[64 * j] = v[j]; v2u o; o.x = pk2(v[j].x, v[j].y); o.y = pk2(v[j].z, v[j].w); o8[64 * j] = o;
            const GAS f32x4* wp = (const GAS f32x4*)wg + 4 * (lane + 64 * j);
#pragma unroll
            for (int q = 0; q < 4; ++q) { const f32x4 w = wp[q]; const float xv = v[j][q]; gl[0] += xv * w.x; gl[1] += xv * w.y; gl[2] += xv * w.z; gl[3] += xv * w.w; } }
#pragma unroll
        for (int g = 0; g < 4; ++g) gl[g] = wave_sum(gl[g]) + bg[g];
        int gsel = 0; float gmax = gl[0];
#pragma unroll
        for (int g = 1; g < 4; ++g) if (gl[g] > gmax) { gmax = gl[g]; gsel = g; }
        float gden = 0.f;
#pragma unroll
        for (int g = 0; g < 4; ++g) gden += __expf(gl[g] - gmax);
        const float gwt = 1.f / gden;
        gsel = __builtin_amdgcn_readfirstlane(gsel);
        float el[8] = {0.f, 0.f, 0.f, 0.f, 0.f, 0.f, 0.f, 0.f};
        const GAS f32x4* wr4 = (const GAS f32x4*)(wrt + (size_t)gsel * DM * 8);
#pragma unroll
        for (int j = 0; j < 8; ++j)
#pragma unroll
            for (int q = 0; q < 4; ++q) { const int d = 4 * (lane + 64 * j) + q; const f32x4 wa = wr4[2 * d], wb = wr4[2 * d + 1]; const float xv = v[j][q];
                el[0] += xv * wa.x; el[1] += xv * wa.y; el[2] += xv * wa.z; el[3] += xv * wa.w; el[4] += xv * wb.x; el[5] += xv * wb.y; el[6] += xv * wb.z; el[7] += xv * wb.w; }
#pragma unroll
        for (int e = 0; e < 8; ++e) el[e] = wave_sum(el[e]) + brt[gsel * 8 + e];
        int i1 = 0; float v1 = el[0];
#pragma unroll
        for (int e = 1; e < 8; ++e) if (el[e] > v1) { v1 = el[e]; i1 = e; }
        int i2 = -1; float v2 = -INFINITY;
#pragma unroll
        for (int e = 0; e < 8; ++e) if (e != i1 && el[e] > v2) { v2 = el[e]; i2 = e; }
        const float e2 = __expf(v2 - v1), w1 = gwt / (1.f + e2), w2 = gwt * e2 / (1.f + e2);
        if (lane < 2) { const int ex = gsel * 8 + (lane == 0 ? i1 : i2); const unsigned slot = __hip_atomic_fetch_add(F.ctl + CW_CNT + 64 * ex, 1u, RLX_AGENT);
            if (slot < (unsigned)MTOK) list[(size_t)ex * MTOK + slot] = (unsigned)m * 2u + (unsigned)lane;
            tokw[2 * m + lane] = lane == 0 ? w1 : w2; }
    }
    LAS float* scr = (LAS float*)(F.lds + RING_OFF + F.wave * 16384);
    bf16* WGU = (bf16*)(F.ws + WS_WGU); bf16* WD = (bf16*)(F.ws + WS_WD);
    constexpr int IGU = (DM / 64) * (DEXP / 32), IDN = (DEXP / 64) * (DM / 32), IPE = 2 * IGU + IDN;
    for (int it = gw; it < NEXP * IPE; it += NGW) {
        const int e = it / IPE; int r = it % IPE;
        if (r < 2 * IGU) { const int up = r >= IGU; if (up) r -= IGU; const int nblk = DEXP / 32, kb = r / nblk, nb = r % nblk, n0 = 32 * nb;
            const float* W = (up ? F.in[19] : F.in[18]) + (size_t)e * DM * DEXP;
            transpose_item(W, DEXP, WGU, DM, (size_t)e * 1024 + 256 * (n0 >> 7) + (n0 & 127) + (up ? 128 : 0), 64 * kb, 64 * kb, n0, scr, lane); }
        else { r -= 2 * IGU; const int nblk = DM / 32, kb = r / nblk, nb = r % nblk;
            transpose_item(F.in[20] + (size_t)e * DEXP * DM, DM, WD, DEXP, (size_t)e * DM + 32 * nb, 64 * kb, 64 * kb, 32 * nb, scr, lane); }
    }
}

__device__ __forceinline__ void p8_final(Frame& F) {
    const int gw = F.vcu * NWAVES + F.wave, NGW = F.G * NWAVES, lane = F.lane;
    float* X1 = F.out; const bf16* Y = (const bf16*)(F.ws + WS_Y); const float* tokw = (const float*)(F.ws + WS_TOKW); const float* g2 = F.in[21]; const float* b2 = F.in[22];
    for (int m = gw; m < MTOK; m += NGW) {
        GAS f32x4* xr = (GAS f32x4*)(X1 + (size_t)m * DM) + lane; const GAS v2u* y0 = (const GAS v2u*)(Y + (size_t)m * DM) + lane; const GAS v2u* y1 = (const GAS v2u*)(Y + ((size_t)MTOK + m) * DM) + lane;
        const float w0 = tokw[2 * m], w1 = tokw[2 * m + 1];
        f32x4 v[8]; float s = 0.f;
#pragma unroll
        for (int j = 0; j < 8; ++j) { const f32x4 x = xr[64 * j]; const v2u a = y0[64 * j], b = y1[64 * j];
            f32x4 ya; ya.x = bflo(a.x); ya.y = bfhi(a.x); ya.z = bflo(a.y); ya.w = bfhi(a.y); f32x4 yb; yb.x = bflo(b.x); yb.y = bfhi(b.x); yb.z = bflo(b.y); yb.w = bfhi(b.y);
            v[j] = x * ALPHA + ya * w0 + yb * w1; s += (v[j].x + v[j].y) + (v[j].z + v[j].w); }
        const float mean = wave_sum(s) * (1.f / DM); float s2 = 0.f;
#pragma unroll
        for (int j = 0; j < 8; ++j) { v[j] = v[j] - mean; s2 += (v[j].x * v[j].x + v[j].y * v[j].y) + (v[j].z * v[j].z + v[j].w * v[j].w); }
        const float rstd = 1.f / sqrtf(wave_sum(s2) * (1.f / DM) + LN_EPS);
#pragma unroll
        for (int j = 0; j < 8; ++j) { const f32x4 gg = ((const GAS f32x4*)g2)[lane + 64 * j], bb = ((const GAS f32x4*)b2)[lane + 64 * j]; xr[64 * j] = v[j] * rstd * gg + bb; }
    }
}

struct Args { const float* in[23]; float* out; unsigned char* ws; int ph_lo, ph_hi, li, pad; };
__global__ void __launch_bounds__(NWAVES * 64, 2) fwd(Args args) {
    extern __shared__ __attribute__((aligned(16))) unsigned char lds[];
    Frame F;
    F.lds = (LAS unsigned char*)lds;
    F.MISC = (volatile LAS unsigned*)(F.lds + MISC_OFF);
    F.tid = threadIdx.x; F.lane = F.tid & 63; F.wave = __builtin_amdgcn_readfirstlane(F.tid >> 6);
    F.G = gridDim.x; { const int bx = blockIdx.x; F.vcu = (F.G % 8 == 0) ? (bx % 8) * (F.G / 8) + bx / 8 : bx; }
    F.ws = args.ws; F.ctl = (gu32*)(args.ws + WS_CTL); F.out = args.out;
#pragma unroll
    for (int i = 0; i < 23; ++i) F.in[i] = args.in[i];
    for (int u = F.tid; u < (LDS_BYTES - LDSCTL_OFF) / 4; u += NWAVES * 64) ((LAS unsigned*)(F.lds + LDSCTL_OFF))[u] = 0u;
    __syncthreads();
    XcdBarrier bar; bar.bar = (unsigned*)(F.ctl + CW_BAR); bar.x = 0; bar.st = nullptr;
    if (N_LAUNCHES == 1) bar = xcd_barrier_post((unsigned*)(F.ctl + CW_BAR), F.MISC + 8);
#define GRID_BAR() do { if (N_LAUNCHES == 1) xcd_barrier(bar); } while (0)
    const int lo = args.ph_lo, hi = args.ph_hi;
#define IN(k) (lo <= (k) && (k) < hi)
#define BOTH(k) (IN(k) && IN((k) + 1))
    unsigned char* ws = args.ws;
    const int bx = (int)blockIdx.x;

    if (IN(0)) { p0_prologue(F); if (BOTH(0)) GRID_BAR(); }

    if (IN(1)) {
        { pg8::Gemm g{(const bf16*)(ws + WS_XB), (const bf16*)(ws + WS_WIN), DM, DM, DM}; pg8::StaticOrder S; S.init(MTOK, IN_DIM, F.G, bx);
          EpiProj E{(bf16*)(ws + WS_PA), (bf16*)(ws + WS_GATES), F.in[5]};
          pg8::gemm_phase<EpiProj, pg8::StaticOrder, true, false>(F.lds + RING_OFF, g, S, E); }
        { pg8::Gemm g{(const bf16*)(ws + WS_MEMN), (const bf16*)(ws + WS_WKV), DM, DM, DM}; pg8::StaticOrder S; S.init(BATCH * MEM_LEN, 2 * MEM_DIM, F.G, (bx + F.G / 2) % F.G);
          EpiPlain E{(bf16*)(ws + WS_MKV), 2 * MEM_DIM};
          pg8::gemm_phase<EpiPlain, pg8::StaticOrder, true, false>(F.lds + RING_OFF, g, S, E); }
        if (BOTH(1)) GRID_BAR();
    }

    if (IN(2)) { p2_mixers(F); if (BOTH(2)) GRID_BAR(); }

    if (IN(3)) {
        const bf16* AC = (const bf16*)(ws + WS_ACAT); const bf16* WC = (const bf16*)(ws + WS_WCAT); const bf16* GT = (const bf16*)(ws + WS_GATES);
        float* macc = (float*)(ws + WS_MACC); bf16* merged = (bf16*)(ws + WS_MERGED);
        pg8::StaticOrder S; S.init(MTOK, DM, F.G, bx);
        { pg8::Gemm g{AC, WC, CONV_DIM, KCAT, KCAT}; EpiMerge<0> E{GT, macc, merged}; pg8::gemm_phase<EpiMerge<0>, pg8::StaticOrder, true, false>(F.lds + RING_OFF, g, S, E); }
        { pg8::Gemm g{AC + 1024, WC + 1024, DIL_OUT, KCAT, KCAT}; EpiMerge<1> E{GT, macc, merged}; pg8::gemm_phase<EpiMerge<1>, pg8::StaticOrder, true, false>(F.lds + RING_OFF, g, S, E); }
        { pg8::Gemm g{AC + 1536, WC + 1536, MEM_DIM, KCAT, KCAT}; EpiMerge<2> E{GT, macc, merged}; pg8::gemm_phase<EpiMerge<2>, pg8::StaticOrder, true, false>(F.lds + RING_OFF, g, S, E); }
        if (BOTH(3)) GRID_BAR();
    }

    if (IN(4)) {
        pg8::Gemm g{(const bf16*)(ws + WS_MERGED), (const bf16*)(ws + WS_WO), DM, DM, DM}; pg8::StaticOrder S; S.init(MTOK, DM, F.G, bx);
        EpiWo E{F.in[0], F.out};
        pg8::gemm_phase<EpiWo, pg8::StaticOrder, true, false>(F.lds + RING_OFF, g, S, E);
        if (BOTH(4)) GRID_BAR();
    }

    if (IN(5)) { p5_ln_route(F); if (BOTH(5)) GRID_BAR(); }

    if (IN(6)) {
        moe_plan(F);
        pg8::Gemm g{(const bf16*)(ws + WS_X1B), (const bf16*)(ws + WS_WGU), DM, DM, DM};
        MoeOrder S{(const LAS int*)(F.lds + TAB_OFF), (const unsigned*)(ws + WS_LIST), 4, F.G, bx};
        EpiGateUp E{(bf16*)(ws + WS_H)};
        pg8::gemm_phase<EpiGateUp, MoeOrder, true, true>(F.lds + RING_OFF, g, S, E);
        if (BOTH(6)) GRID_BAR();
    }

    if (IN(7)) {
        moe_plan(F);
        pg8::Gemm g{(const bf16*)(ws + WS_H), (const bf16*)(ws + WS_WD), DEXP, DEXP, DEXP};
        MoeOrder S{(const LAS int*)(F.lds + TAB_OFF), (const unsigned*)(ws + WS_LIST), 8, F.G, bx};
        EpiDown E{(bf16*)(ws + WS_Y), (const unsigned*)(ws + WS_LIST)};
        pg8::gemm_phase<EpiDown, MoeOrder, true, false>(F.lds + RING_OFF, g, S, E);
        if (BOTH(7)) GRID_BAR();
    }

    if (IN(8)) { p8_final(F); }
#undef IN
#undef BOTH
#undef GRID_BAR
}

extern "C" void kernel_launch(void* const* d_in, const int* in_sizes, int n_in, void* d_out, int out_size, void* d_ws, size_t ws_size, hipStream_t stream) {
    static int grid = 0;
    if (grid == 0) {
        if (n_in != 23 || in_sizes[0] != MTOK * DM || out_size != MTOK * DM || ws_size < WS_END) { fprintf(stderr, "kernel_launch: unexpected shapes/workspace (n_in %d, ws %zu); nothing launched\n", n_in, ws_size); grid = -1; return; }
        int dev = 0, cus = 0, per_cu = 0;
        if (hipGetDevice(&dev) != hipSuccess || hipDeviceGetAttribute(&cus, hipDeviceAttributeMultiprocessorCount, dev) != hipSuccess) { grid = -1; return; }
        if (hipFuncSetAttribute((const void*)fwd, hipFuncAttributeMaxDynamicSharedMemorySize, LDS_BYTES) != hipSuccess) { fprintf(stderr, "kernel_launch: hipFuncSetAttribute failed\n"); grid = -1; return; }
        if (hipOccupancyMaxActiveBlocksPerMultiprocessor(&per_cu, (const void*)fwd, NWAVES * 64, LDS_BYTES) != hipSuccess || per_cu < 1) fprintf(stderr, "kernel_launch: occupancy query reports %d\n", per_cu);
        (void)hipGetLastError();
        grid = cus;
    }
    if (grid < 0) return;
    if (hipMemsetAsync((char*)d_ws + WS_CTL, 0, CTL_ZERO_BYTES, stream) != hipSuccess) return;
    Args a{};
    for (int i = 0; i < 23; ++i) a.in[i] = (const float*)d_in[i];
    a.out = (float*)d_out; a.ws = (unsigned char*)d_ws;
    for (int li = 0; li < N_LAUNCHES; ++li) {
        a.ph_lo = (N_LAUNCHES == 1) ? 0 : li; a.ph_hi = (N_LAUNCHES == 1) ? N_PHASES : li + 1; a.li = li;
        hipLaunchKernelGGL(fwd, dim3(grid), dim3(NWAVES * 64), LDS_BYTES, stream, a);
        if (hipPeekAtLastError() != hipSuccess) { fprintf(stderr, "kernel_launch: launch %d failed\n", li); break; }
    }
}
```

```cpp
#include <hip/hip_runtime.h>
#include <cstdio>
#include <cstdint>

#ifndef MK_N_LAUNCHES
#define MK_N_LAUNCHES 1
#endif

namespace pg8 {
#define PG8_LAS __attribute__((address_space(3)))
typedef unsigned short bf16_t;
typedef short bf16x8 __attribute__((ext_vector_type(8)));
typedef float f32x4 __attribute__((ext_vector_type(4)));
typedef unsigned u32x4 __attribute__((ext_vector_type(4)));
typedef unsigned u32x2 __attribute__((ext_vector_type(2)));
constexpr int BM = 256, BK = 64, HALF = 128, HTB = HALF * BK * 2, STAGE_BYTES = 8 * HTB, NXCD = 8, WGM = 8;

__host__ __device__ __forceinline__ int lds_byte(int r, int c) { const int st = (r >> 4) * 2 + (c >> 5), rr = r & 15, cc = c & 31, ob = rr * 64 + cc * 2; return st * 1024 + (ob ^ (((ob >> 9) & 1) << 5)); }
__host__ __device__ __forceinline__ void stage_rc(int b, int& R, int& C) { const int st = b / 1024, sb = b % 1024, swz = sb ^ (((sb >> 9) & 1) << 5); R = (st >> 1) * 16 + swz / 64; C = (st & 1) * 32 + (swz % 64) / 2; }
__host__ __device__ __forceinline__ int perm32(int rho) { const int n = rho >> 4, i = rho & 15; return 8 * (i >> 2) + 4 * n + (i & 3); }

struct Unit { int pm, pn, pb, aux, nv; };
struct Gemm { const bf16_t* A; const bf16_t* Bt; int K, lda, ldb; };

struct StaticOrder {
    int nM, nN, nwg, G, c;
    __host__ __device__ void init(int M, int N, int G_, int c_) { nM = M / BM; nN = N / BM; nwg = nM * nN; G = G_; c = c_; }
    __host__ __device__ bool next(int i, Unit& u) const {
        const long L = (long)i * G + c; if (L >= nwg) return false;
        int wgid = (int)L; { const int q = nwg / NXCD, r = nwg % NXCD, xcd = wgid % NXCD, off = wgid / NXCD; wgid = (xcd < r ? xcd * (q + 1) : r * (q + 1) + (xcd - r) * q) + off; }
        const int nig = WGM * nN, gid = wgid / nig, fm = gid * WGM, gsz = (nM - fm) < WGM ? (nM - fm) : WGM;
        u.pm = fm + ((wgid % nig) % gsz); u.pn = (wgid % nig) / gsz; u.pb = u.pn; u.aux = 0; u.nv = 256; return true;
    }
    __device__ __forceinline__ unsigned row_of(const Unit&, int r) const { return (unsigned)r; }
    __device__ __forceinline__ void a_ready(const Unit&) const {}
    __device__ __forceinline__ void done(const Unit&) const {}
};

__device__ __forceinline__ unsigned cvt_pk_bf16(float lo, float hi) { unsigned r; asm volatile("v_cvt_pk_bf16_f32 %0, %1, %2" : "=v"(r) : "v"(lo), "v"(hi)); return r; }

template <class Epi, class Sched, bool ALIGN_EPI, bool GATHER>
__device__ __forceinline__ void gemm_phase(PG8_LAS unsigned char* lds, const Gemm g, const Sched& S, const Epi& E) {
    const int tid = threadIdx.x, wid = __builtin_amdgcn_readfirstlane(tid >> 6), lane = tid & 63, wr = wid >> 2, wc = wid & 3, fr = lane & 15, fq = lane >> 4;
    const int K = g.K, nt = K / BK;
    unsigned voffB[2], cvA0[2], cvA1[2], nvA0[2], nvA1[2]; int RA[2], CA[2];
#pragma unroll
    for (int i = 0; i < 2; ++i) { int R, C; stage_rc(tid * 16 + i * 8192, R, C); const int Rb = Epi::PERM ? ((R & ~31) + perm32(R & 31)) : R;
        RA[i] = R; CA[i] = C; voffB[i] = (unsigned)(Rb * g.ldb + C) * 2u; }
    const size_t kstep = (size_t)(BK * 2);
    const size_t hstepB = (size_t)HALF * g.ldb * 2, tstepB = 2 * hstepB, tstepA = (size_t)BM * g.lda * 2;
    const unsigned ldsw = (unsigned)wid * 1024u;
    const int aoff = lds_byte(wr * 64 + fr, fq * 8), boff = lds_byte(wc * 32 + fr, fq * 8);
#define PG8_SA(b, h) (((b) * 2 + (h)) * HTB)
#define PG8_SB(b, h) ((4 + (b) * 2 + (h)) * HTB)
#define PG8_STAGE(bufoff, gbase, voff) do { _Pragma("unroll") for (int _i = 0; _i < 2; ++_i) \
        __builtin_amdgcn_global_load_lds((const unsigned*)((const char*)(gbase) + (voff)[_i]), (PG8_LAS unsigned*)(lds + (bufoff) + ldsw + _i * 8192), 16, 0, 0); } while (0)
#define PG8_LDA(dst, b, h) do { _Pragma("unroll") for (int m = 0; m < 4; ++m) _Pragma("unroll") for (int k = 0; k < 2; ++k) dst[m][k] = *(const PG8_LAS bf16x8*)(lds + PG8_SA(b, h) + aoff + m * 2048 + k * 1024); } while (0)
#define PG8_LDB(dst, b, h) do { _Pragma("unroll") for (int n = 0; n < 2; ++n) _Pragma("unroll") for (int k = 0; k < 2; ++k) dst[n][k] = *(const PG8_LAS bf16x8*)(lds + PG8_SB(b, h) + boff + n * 2048 + k * 1024); } while (0)
#define PG8_MMA(ai, bj, At, Bt) do { __builtin_amdgcn_s_setprio(1); _Pragma("unroll") for (int m = 0; m < 4; ++m) _Pragma("unroll") for (int n = 0; n < 2; ++n) _Pragma("unroll") for (int k = 0; k < 2; ++k) \
        acc[ai][bj][m][n] = __builtin_amdgcn_mfma_f32_16x16x32_bf16(Bt[n][k], At[m][k], acc[ai][bj][m][n], 0, 0, 0); __builtin_amdgcn_s_setprio(0); } while (0)
#define PG8_WAIT_V(n) asm volatile("s_waitcnt vmcnt(" #n ")" ::: "memory")
#define PG8_WAIT_L(n) asm volatile("s_waitcnt lgkmcnt(" #n ")" ::: "memory")
#define PG8_BAR __builtin_amdgcn_s_barrier()
#define PG8_SCHED __builtin_amdgcn_sched_barrier(0)
#define PG8_ROWS(U, d0, d1) do { if constexpr (GATHER) { const unsigned _r0 = S.row_of(U, RA[0]), _r1 = S.row_of(U, RA[1]), _r2 = S.row_of(U, RA[0] + HALF), _r3 = S.row_of(U, RA[1] + HALF); \
        d0[0] = (_r0 * (unsigned)g.lda + (unsigned)CA[0]) * 2u; d0[1] = (_r1 * (unsigned)g.lda + (unsigned)CA[1]) * 2u; d1[0] = (_r2 * (unsigned)g.lda + (unsigned)CA[0]) * 2u; d1[1] = (_r3 * (unsigned)g.lda + (unsigned)CA[1]) * 2u; } \
      else { _Pragma("unroll") for (int _i = 0; _i < 2; ++_i) { d0[_i] = (unsigned)(RA[_i] * g.lda + CA[_i]) * 2u; d1[_i] = d0[_i] + (unsigned)(HALF * g.lda * 2); } } } while (0)
    Unit cur, nxt; int ui = 0;
    if (!S.next(0, cur)) return;
    f32x4 acc[2][2][4][2];
#pragma unroll
    for (int a = 0; a < 2; ++a)
#pragma unroll
        for (int b = 0; b < 2; ++b)
#pragma unroll
            for (int m = 0; m < 4; ++m)
#pragma unroll
                for (int n = 0; n < 2; ++n) acc[a][b][m][n] = (f32x4){0.f, 0.f, 0.f, 0.f};
    bf16x8 At[4][2], B0[2][2], B1[2][2];
    const char* cA = GATHER ? (const char*)g.A : (const char*)g.A + (size_t)cur.pm * tstepA; const char* cB = (const char*)g.Bt + (size_t)cur.pb * tstepB;
    S.a_ready(cur);
    PG8_ROWS(cur, cvA0, cvA1);
    PG8_STAGE(PG8_SB(0, 0), cB, voffB); PG8_STAGE(PG8_SB(0, 1), cB + hstepB, voffB); PG8_STAGE(PG8_SA(0, 0), cA, cvA0); PG8_STAGE(PG8_SA(0, 1), cA, cvA1);
    if (wr == 1) PG8_BAR;
    PG8_WAIT_V(2); PG8_BAR;
    PG8_STAGE(PG8_SB(1, 0), cB + kstep, voffB); PG8_STAGE(PG8_SA(1, 0), cA + kstep, cvA0); PG8_STAGE(PG8_SB(1, 1), cB + hstepB + kstep, voffB);
    PG8_WAIT_V(6); PG8_BAR;
    for (;;) {
        const bool has_next = S.next(ui + 1, nxt);
        const char* nA = has_next ? (GATHER ? (const char*)g.A : (const char*)g.A + (size_t)nxt.pm * tstepA) : cA; const char* nB = has_next ? (const char*)g.Bt + (size_t)nxt.pb * tstepB : cB;
#pragma unroll
        for (int i = 0; i < 2; ++i) { nvA0[i] = cvA0[i]; nvA1[i] = cvA1[i]; }
        for (int t = 0; t < nt; t += 2) {
            const bool last = (t == nt - 2);
            const char* a1 = cA + (size_t)(t + 1) * kstep;
            const char* a2 = last ? nA : cA + (size_t)(t + 2) * kstep; const char* b2 = last ? nB : cB + (size_t)(t + 2) * kstep;
            const char* a3 = a2 + kstep; const char* b3 = b2 + kstep;
            if (last && has_next) { S.a_ready(nxt); if constexpr (GATHER) { PG8_ROWS(nxt, nvA0, nvA1); } }
            unsigned xA0[2], xA1[2];
#pragma unroll
            for (int i = 0; i < 2; ++i) { xA0[i] = last ? nvA0[i] : cvA0[i]; xA1[i] = last ? nvA1[i] : cvA1[i]; }
            PG8_LDB(B0, 0, 0); PG8_LDB(B1, 0, 1); PG8_SCHED; PG8_LDA(At, 0, 0); PG8_STAGE(PG8_SA(1, 1), a1, cvA1);
            PG8_WAIT_V(8); PG8_WAIT_L(0); PG8_BAR; PG8_MMA(0, 0, At, B0); PG8_MMA(0, 1, At, B1); PG8_BAR; PG8_SCHED;
            PG8_LDA(At, 0, 1); PG8_STAGE(PG8_SB(0, 0), b2, voffB); PG8_STAGE(PG8_SB(0, 1), b2 + hstepB, voffB); PG8_STAGE(PG8_SA(0, 0), a2, xA0);
            PG8_WAIT_V(8); PG8_WAIT_L(0); PG8_BAR; PG8_MMA(1, 0, At, B0); PG8_MMA(1, 1, At, B1); PG8_BAR; PG8_SCHED;
            PG8_LDB(B0, 1, 0); PG8_LDB(B1, 1, 1); PG8_SCHED; PG8_LDA(At, 1, 0); PG8_STAGE(PG8_SA(0, 1), a2, xA1);
            PG8_WAIT_V(8); PG8_WAIT_L(0); PG8_BAR; PG8_MMA(0, 0, At, B0); PG8_MMA(0, 1, At, B1); PG8_BAR; PG8_SCHED;
            PG8_LDA(At, 1, 1); PG8_STAGE(PG8_SB(1, 0), b3, voffB); PG8_STAGE(PG8_SB(1, 1), b3 + hstepB, voffB); PG8_STAGE(PG8_SA(1, 0), a3, xA0);
            PG8_WAIT_V(8); PG8_WAIT_L(0); PG8_BAR; PG8_MMA(1, 0, At, B0); PG8_MMA(1, 1, At, B1); PG8_BAR; PG8_SCHED;
        }
        if constexpr (ALIGN_EPI) { if (wr == 0) PG8_BAR; }
        E(acc, cur, wr, wc, fr, fq); S.done(cur);
        if (!has_next) break;
#pragma unroll
        for (int a = 0; a < 2; ++a)
#pragma unroll
            for (int b = 0; b < 2; ++b)
#pragma unroll
                for (int m = 0; m < 4; ++m)
#pragma unroll
                    for (int n = 0; n < 2; ++n) acc[a][b][m][n] = (f32x4){0.f, 0.f, 0.f, 0.f};
        cur = nxt; cA = nA; cB = nB; ++ui;
#pragma unroll
        for (int i = 0; i < 2; ++i) { cvA0[i] = nvA0[i]; cvA1[i] = nvA1[i]; }
        if constexpr (ALIGN_EPI) { if (wr == 1) PG8_BAR; }
    }
    PG8_WAIT_V(0);
    if constexpr (!ALIGN_EPI) { if (wr == 0) PG8_BAR; }
    PG8_BAR;
#undef PG8_SA
#undef PG8_SB
#undef PG8_STAGE
#undef PG8_LDA
#undef PG8_LDB
#undef PG8_MMA
#undef PG8_WAIT_V
#undef PG8_WAIT_L
#undef PG8_BAR
#undef PG8_SCHED
#undef PG8_ROWS
}
}

constexpr int NWAVES = 8;
constexpr int N_LAUNCHES = MK_N_LAUNCHES;
constexpr int N_PHASES = 9;
constexpr int BATCH = 8, SEQ = 2048, DM = 2048, MTOK = BATCH * SEQ;
constexpr int CONV_DIM = 1024, DIL_DIM = 1536, DIL_OUT = 512, MEM_LEN = 256, MEM_DIM = 1024, IN_DIM = 14848;
constexpr int NA = 8704, NGATE = 6144, KCAT = 2560;
constexpr int PA_CB = 0, PA_CC = 1024, PA_CH = 2048, PA_Q = 3072, PA_K = 4608, PA_V = 6144, PA_MQ = 7680;
constexpr int NEXP = 32, DEXP = 512, HROWS = 40960;
constexpr float LN_EPS = 1e-5f;
constexpr float ALPHA = 1.189207115002721f;

constexpr size_t MiB = 1u << 20;
constexpr size_t WS_CTL = 0, CTL_ZERO_BYTES = 1 * MiB;
constexpr size_t WS_LIST = 1 * MiB, WS_TOKW = 3 * MiB;
constexpr size_t WS_WCAT = 8 * MiB, WS_WKV = 18 * MiB, WS_WO = 26 * MiB, WS_MEMN = 34 * MiB, WS_MKV = 42 * MiB;
constexpr size_t WS_WIN = 50 * MiB, WS_XB = 108 * MiB, WS_PA = 172 * MiB, WS_GATES = 444 * MiB, WS_END = 636 * MiB;
constexpr size_t WS_ACAT = 50 * MiB;
constexpr size_t WS_MACC = 172 * MiB;
constexpr size_t WS_MERGED = 300 * MiB;
constexpr size_t WS_X1B = 364 * MiB;
constexpr size_t WS_WGU = 444 * MiB;
constexpr size_t WS_WD = 572 * MiB;
constexpr size_t WS_H = 50 * MiB;
constexpr size_t WS_Y = 172 * MiB;
static_assert(WS_WIN + (size_t)IN_DIM * DM * 2 <= WS_XB && WS_XB + (size_t)MTOK * DM * 2 <= WS_PA && WS_PA + (size_t)MTOK * NA * 2 <= WS_GATES && WS_GATES + (size_t)MTOK * NGATE * 2 <= WS_END, "ws map");
static_assert(WS_ACAT + (size_t)MTOK * KCAT * 2 <= WS_PA && WS_MACC + (size_t)MTOK * DM * 4 <= WS_MERGED && WS_MERGED + (size_t)MTOK * DM * 2 <= WS_X1B && WS_X1B + (size_t)MTOK * DM * 2 <= WS_WGU, "ws map 2");
static_assert(WS_WGU + (size_t)NEXP * 1024 * DM * 2 <= WS_WD && WS_WD + (size_t)NEXP * DM * DEXP * 2 <= WS_END && WS_H + (size_t)HROWS * DEXP * 2 <= WS_PA && WS_Y + (size_t)2 * MTOK * DM * 2 <= WS_X1B, "ws map 3");

constexpr int CW_TMO = 0, CW_CODE = 1, CW_BAR = 4096, CW_CNT = 16384;

constexpr int RING_OFF = 0, RING_BYTES = 131072;
constexpr int LDSCTL_OFF = RING_BYTES, MISC_OFF = LDSCTL_OFF + 320, TAB_OFF = LDSCTL_OFF + 1024;
constexpr int LDS_BYTES = 147456;
static_assert(TAB_OFF + 2048 <= LDS_BYTES, "LDS map");

#define GAS __attribute__((address_space(1)))
#define LAS __attribute__((address_space(3)))
typedef unsigned short bf16;
typedef unsigned v4u __attribute__((ext_vector_type(4)));
typedef unsigned v2u __attribute__((ext_vector_type(2)));
typedef float f32x4 __attribute__((ext_vector_type(4)));
typedef GAS unsigned gu32;
#define RLX_AGENT __ATOMIC_RELAXED, __HIP_MEMORY_SCOPE_AGENT
#define LDS_WAIT() asm volatile("s_waitcnt lgkmcnt(0)" ::: "memory")
#define VM_WAIT() asm volatile("s_waitcnt vmcnt(0)" ::: "memory")
__device__ __forceinline__ unsigned f2bf(float f) { unsigned u = __builtin_bit_cast(unsigned, f); return (u + 0x7fffu + ((u >> 16) & 1u)) >> 16; }
__device__ __forceinline__ unsigned pk2(float lo, float hi) { return f2bf(lo) | (f2bf(hi) << 16); }
__device__ __forceinline__ float bflo(unsigned w) { return __builtin_bit_cast(float, w << 16); }
__device__ __forceinline__ float bfhi(unsigned w) { return __builtin_bit_cast(float, w & 0xffff0000u); }
__device__ __forceinline__ float bf1(bf16 b) { return __builtin_bit_cast(float, (unsigned)b << 16); }

#define XB_TMO      128
#define XB_XCNT(j)  (256  + 64 * (j))
#define XB_XSUB(j)  (1280 + 64 * (j))
#define XB_XGEN(j)  (2304 + 64 * (j))
#define XB_TOP      3328
#define XB_TOPGEN   3392
#define XCD_BAR_WORDS 3456
#define XB_SPIN_CAP (1u << 18)
__device__ __forceinline__ unsigned xb_ld(unsigned* p)              { return __hip_atomic_load(p, __ATOMIC_RELAXED, __HIP_MEMORY_SCOPE_AGENT); }
__device__ __forceinline__ unsigned xb_add(unsigned* p, unsigned v) { return __hip_atomic_fetch_add(p, v, __ATOMIC_RELAXED, __HIP_MEMORY_SCOPE_AGENT); }
__device__ __forceinline__ unsigned xb_xcc_id() { return (unsigned)__builtin_amdgcn_s_getreg((3 << 11) | 20) & 0xFu; }
#define XB_SPIN(cond, bar) do { unsigned _sp = 0; while (cond) { __builtin_amdgcn_s_sleep(1); \
    if ((++_sp & 255u) == 0u) { if (xb_ld(&(bar)[XB_TMO])) break; if (_sp > XB_SPIN_CAP) { atomicAdd(&(bar)[XB_TMO], 1u); break; } } } } while (0)
struct XcdBarrier { unsigned* bar; unsigned x; volatile LAS unsigned* st; };
__device__ __forceinline__ XcdBarrier xcd_barrier_post(unsigned* bar, volatile LAS unsigned* st) {
    XcdBarrier b; b.bar = bar; b.x = xb_xcc_id(); b.st = st;
    if (threadIdx.x == 0) (void)xb_add(&bar[XB_XCNT(b.x)], 1u);
    return b;
}
__device__ __forceinline__ void xcd_barrier_complete(unsigned* bar, unsigned x, unsigned& nloc, unsigned& nx) {
    const unsigned G = gridDim.x * gridDim.y * gridDim.z;
    unsigned sum, cnt, mine, sp = 0u;
    for (;;) {
        sum = 0u; cnt = 0u; mine = 0u;
#pragma unroll
        for (unsigned j = 0; j < 16; ++j) { const unsigned c = xb_ld(&bar[XB_XCNT(j)]); sum += c; cnt += (c > 0u) ? 1u : 0u; mine = (j == x) ? c : mine; }
        if (sum == G) break;
        __builtin_amdgcn_s_sleep(1);
        if ((++sp & 255u) == 0u) { if (xb_ld(&bar[XB_TMO])) break; if (sp > XB_SPIN_CAP) { atomicAdd(&bar[XB_TMO], 1u); break; } }
    }
    nloc = mine > 0u ? mine : 1u; nx = cnt > 0u ? cnt : 1u;
}
__device__ __forceinline__ void xcd_barrier(const XcdBarrier& b) {
    asm volatile("s_waitcnt vmcnt(0)" ::: "memory");
    __syncthreads();
    if (threadIdx.x == 0) {
        unsigned* bar = b.bar;
        __builtin_amdgcn_s_waitcnt(0);
        unsigned nloc = b.st[0], nx = b.st[1];
        if (nloc == 0u) { xcd_barrier_complete(bar, b.x, nloc, nx); b.st[0] = nloc; b.st[1] = nx; }
        const unsigned old = xb_add(&bar[XB_XSUB(b.x)], 1u);
        const unsigned gen = old / nloc;
        if (old + 1u == (gen + 1u) * nloc) {
            __builtin_amdgcn_fence(__ATOMIC_RELEASE, "agent");
            asm volatile("s_waitcnt vmcnt(0)" ::: "memory");
            const unsigned og = xb_add(&bar[XB_TOP], 1u);
            const unsigned tg = og / nx;
            if (og + 1u == (tg + 1u) * nx) xb_add(&bar[XB_TOPGEN], 1u);
            else XB_SPIN(xb_ld(&bar[XB_TOPGEN]) == tg, bar);
            __builtin_amdgcn_fence(__ATOMIC_ACQUIRE, "agent");
            xb_add(&bar[XB_XGEN(b.x)], 1u);
            asm volatile("s_waitcnt vmcnt(0)" ::: "memory");
        } else {
            XB_SPIN(xb_ld(&bar[XB_XGEN(b.x)]) == gen, bar);
            __builtin_amdgcn_fence(__ATOMIC_ACQUIRE, "agent");
            asm volatile("s_waitcnt vmcnt(0)" ::: "memory");
        }
    }
    __syncthreads();
}

struct Frame {
    LAS unsigned char* lds;
    volatile LAS unsigned* MISC;
    gu32* ctl;
    int tid, lane, wave;
    int vcu, G;
    unsigned char* ws;
    const float* in[23];
    float* out;
};

__device__ __forceinline__ float wave_sum(float v) {
#pragma unroll
    for (int o = 1; o < 64; o <<= 1) v += __shfl_xor(v, o);
    return v;
}
__device__ __forceinline__ float wave_max(float v) {
#pragma unroll
    for (int o = 1; o < 64; o <<= 1) v = fmaxf(v, __shfl_xor(v, o));
    return v;
}

__device__ __forceinline__ void transpose_item(const float* W, int N, bf16* WT, int ldt, size_t drow0, int dcol0, int k0, int n0, LAS float* scr, int lane) {
#pragma unroll 8
    for (int i = 0; i < 32; ++i) { const int kk = 2 * i + (lane >> 5); scr[kk * 33 + (lane & 31)] = W[(size_t)(k0 + kk) * N + n0 + (lane & 31)]; }
    LDS_WAIT(); asm volatile("" ::: "memory");
    const int c = lane & 7;
#pragma unroll
    for (int j = 0; j < 4; ++j) { const int n = (lane >> 3) + 8 * j; const LAS float* s = scr + (8 * c) * 33 + n;
        v4u o; o.x = pk2(s[0 * 33], s[1 * 33]); o.y = pk2(s[2 * 33], s[3 * 33]); o.z = pk2(s[4 * 33], s[5 * 33]); o.w = pk2(s[6 * 33], s[7 * 33]);
        *(GAS v4u*)(WT + (drow0 + n) * ldt + dcol0 + 8 * c) = o; }
    LDS_WAIT(); asm volatile("" ::: "memory");
}
__device__ __forceinline__ void transpose_matrix(Frame& F, LAS float* scr, const float* W, int K, int N, bf16* WT, int ldt, int dcol_base, int gw, int NGW) {
    const int nblk = N / 32, nitems = (K / 64) * nblk;
    for (int it = gw; it < nitems; it += NGW) { const int kb = it / nblk, nb = it % nblk; transpose_item(W, N, WT, ldt, (size_t)(32 * nb), dcol_base + 64 * kb, 64 * kb, 32 * nb, scr, F.lane); }
}

__device__ __forceinline__ void p0_prologue(Frame& F) {
    LAS float* scr = (LAS float*)(F.lds + RING_OFF + F.wave * 16384);
    const int gw = F.vcu * NWAVES + F.wave, NGW = F.G * NWAVES;
    unsigned char* ws = F.ws;
    transpose_matrix(F, scr, F.in[4], DM, IN_DIM, (bf16*)(ws + WS_WIN), DM, 0, gw, NGW);
    transpose_matrix(F, scr, F.in[7], CONV_DIM, DM, (bf16*)(ws + WS_WCAT), KCAT, 0, gw, NGW);
    transpose_matrix(F, scr, F.in[8], DIL_OUT, DM, (bf16*)(ws + WS_WCAT), KCAT, 1024, gw, NGW);
    transpose_matrix(F, scr, F.in[10], MEM_DIM, DM, (bf16*)(ws + WS_WCAT), KCAT, 1536, gw, NGW);
    transpose_matrix(F, scr, F.in[9], DM, 2 * MEM_DIM, (bf16*)(ws + WS_WKV), DM, 0, gw, NGW);
    transpose_matrix(F, scr, F.in[11], DM, DM, (bf16*)(ws + WS_WO), DM, 0, gw, NGW);
    { const GAS f32x4* x4 = (const GAS f32x4*)F.in[0]; GAS v4u* o4 = (GAS v4u*)(ws + WS_XB); const size_t n8 = (size_t)MTOK * DM / 8;
      for (size_t i = (size_t)gw * 64 + F.lane; i < n8; i += (size_t)NGW * 64) { const f32x4 a = x4[2 * i], b = x4[2 * i + 1]; v4u o; o.x = pk2(a.x, a.y); o.y = pk2(a.z, a.w); o.z = pk2(b.x, b.y); o.w = pk2(b.z, b.w); o4[i] = o; } }
    { const float* gm = F.in[2]; const float* bm = F.in[3]; bf16* mo = (bf16*)(ws + WS_MEMN);
      for (int m = gw; m < BATCH * MEM_LEN; m += NGW) {
        const GAS f32x4* xr = (const GAS f32x4*)(F.in[1] + (size_t)m * DM) + F.lane; f32x4 v[8]; float s = 0.f;
#pragma unroll
        for (int j = 0; j < 8; ++j) { v[j] = xr[64 * j]; s += (v[j].x + v[j].y) + (v[j].z + v[j].w); }
        const float mean = wave_sum(s) * (1.f / DM); float s2 = 0.f;
#pragma unroll
        for (int j = 0; j < 8; ++j) { v[j] = v[j] - mean; s2 += (v[j].x * v[j].x + v[j].y * v[j].y) + (v[j].z * v[j].z + v[j].w * v[j].w); }
        const float rstd = 1.f / sqrtf(wave_sum(s2) * (1.f / DM) + LN_EPS);
        GAS v2u* o8 = (GAS v2u*)(mo + (size_t)m * DM) + F.lane;
#pragma unroll
        for (int j = 0; j < 8; ++j) { const f32x4 gg = ((const GAS f32x4*)gm)[F.lane + 64 * j], bb = ((const GAS f32x4*)bm)[F.lane + 64 * j]; const f32x4 y = v[j] * rstd * gg + bb;
            v2u o; o.x = pk2(y.x, y.y); o.y = pk2(y.z, y.w); o8[64 * j] = o; }
      } }
}

using pg8::Unit; using pg8::cvt_pk_bf16; using pg8::HALF; using pg8::BM;
struct EpiProj {
    static constexpr bool PERM = true;
    bf16* PA; bf16* GT; const float* bias;
    __device__ __forceinline__ void operator()(const f32x4 (&acc)[2][2][4][2], const Unit& u, int wr, int wc, int fr, int fq) const {
        const int row0 = u.pm * BM + wr * 64 + fr; const bool isg = u.pn >= NA / 256;
        bf16* base = isg ? GT : PA; const int ldc = isg ? NGATE : NA; const int colt = isg ? (u.pn - NA / 256) * BM : u.pn * BM;
        const int col0 = colt + wc * 32 + 8 * fq, bcol0 = u.pn * BM + wc * 32 + 8 * fq;
        f32x4 bv[2][2];
#pragma unroll
        for (int bj = 0; bj < 2; ++bj)
#pragma unroll
            for (int n = 0; n < 2; ++n) bv[bj][n] = *(const f32x4*)(bias + bcol0 + bj * HALF + 4 * n);
#pragma unroll
        for (int ai = 0; ai < 2; ++ai)
#pragma unroll
            for (int m = 0; m < 4; ++m) { bf16* rowp = base + (size_t)(row0 + ai * HALF + m * 16) * ldc + col0;
#pragma unroll
                for (int bj = 0; bj < 2; ++bj) { f32x4 v0 = acc[ai][bj][m][0] + bv[bj][0], v1 = acc[ai][bj][m][1] + bv[bj][1];
                    if (isg) {
#pragma unroll
                        for (int j = 0; j < 4; ++j) { v0[j] = __builtin_amdgcn_rcpf(1.f + __builtin_amdgcn_exp2f(-1.4426950408889634f * v0[j])); v1[j] = __builtin_amdgcn_rcpf(1.f + __builtin_amdgcn_exp2f(-1.4426950408889634f * v1[j])); } }
                    pg8::u32x4 w; w.x = cvt_pk_bf16(v0[0], v0[1]); w.y = cvt_pk_bf16(v0[2], v0[3]); w.z = cvt_pk_bf16(v1[0], v1[1]); w.w = cvt_pk_bf16(v1[2], v1[3]);
                    *(pg8::u32x4*)(rowp + bj * HALF) = w; } }
    }
};
struct EpiPlain {
    static constexpr bool PERM = true;
    bf16* O; int ldc;
    __device__ __forceinline__ void operator()(const f32x4 (&acc)[2][2][4][2], const Unit& u, int wr, int wc, int fr, int fq) const {
        const int row0 = u.pm * BM + wr * 64 + fr, col0 = u.pn * BM + wc * 32 + 8 * fq;
#pragma unroll
        for (int ai = 0; ai < 2; ++ai)
#pragma unroll
            for (int m = 0; m < 4; ++m) { bf16* rowp = O + (size_t)(row0 + ai * HALF + m * 16) * ldc + col0;
#pragma unroll
                for (int bj = 0; bj < 2; ++bj) { const f32x4 v0 = acc[ai][bj][m][0], v1 = acc[ai][bj][m][1];
                    pg8::u32x4 w; w.x = cvt_pk_bf16(v0[0], v0[1]); w.y = cvt_pk_bf16(v0[2], v0[3]); w.z = cvt_pk_bf16(v1[0], v1[1]); w.w = cvt_pk_bf16(v1[2], v1[3]);
                    *(pg8::u32x4*)(rowp + bj * HALF) = w; } }
    }
};
template <int MODE> struct EpiMerge {
    static constexpr bool PERM = false;
    const bf16* GT; float* macc; bf16* merged;
    __device__ __forceinline__ void operator()(const f32x4 (&acc)[2][2][4][2], const Unit& u, int wr, int wc, int fr, int fq) const {
        const int row0 = u.pm * BM + wr * 64 + fr, col0 = u.pn * BM + wc * 32 + 4 * fq;
#pragma unroll
        for (int ai = 0; ai < 2; ++ai)
#pragma unroll
            for (int m = 0; m < 4; ++m) { const size_t row = (size_t)(row0 + ai * HALF + m * 16);
#pragma unroll
                for (int bj = 0; bj < 2; ++bj)
#pragma unroll
                    for (int n = 0; n < 2; ++n) { const int col = col0 + bj * HALF + n * 16;
                        const v2u gw = *(const v2u*)(GT + row * NGATE + MODE * DM + col);
                        f32x4 gv; gv.x = bflo(gw.x); gv.y = bfhi(gw.x); gv.z = bflo(gw.y); gv.w = bfhi(gw.y);
                        f32x4 r = gv * acc[ai][bj][m][n];
                        if (MODE > 0) r += *(const f32x4*)(macc + row * DM + col);
                        if (MODE < 2) *(f32x4*)(macc + row * DM + col) = r;
                        else { v2u o; o.x = cvt_pk_bf16(r.x, r.y); o.y = cvt_pk_bf16(r.z, r.w); *(v2u*)(merged + row * DM + col) = o; } } }
    }
};
struct EpiWo {
    static constexpr bool PERM = false;
    const float* x; float* y;
    __device__ __forceinline__ void operator()(const f32x4 (&acc)[2][2][4][2], const Unit& u, int wr, int wc, int fr, int fq) const {
        const int row0 = u.pm * BM + wr * 64 + fr, col0 = u.pn * BM + wc * 32 + 4 * fq;
#pragma unroll
        for (int ai = 0; ai < 2; ++ai)
#pragma unroll
            for (int m = 0; m < 4; ++m) { const size_t off = (size_t)(row0 + ai * HALF + m * 16) * DM + col0;
#pragma unroll
                for (int bj = 0; bj < 2; ++bj)
#pragma unroll
                    for (int n = 0; n < 2; ++n) { const f32x4 xv = *(const f32x4*)(x + off + bj * HALF + n * 16); *(f32x4*)(y + off + bj * HALF + n * 16) = xv * ALPHA + acc[ai][bj][m][n]; } }
    }
};
struct EpiGateUp {
    static constexpr bool PERM = true;
    bf16* H;
    __device__ __forceinline__ void operator()(const f32x4 (&acc)[2][2][4][2], const Unit& u, int wr, int wc, int fr, int fq) const {
        const int row0 = u.pm * BM + wr * 64 + fr, col0 = u.pn * HALF + wc * 32 + 8 * fq;
#pragma unroll
        for (int ai = 0; ai < 2; ++ai)
#pragma unroll
            for (int m = 0; m < 4; ++m) { bf16* rowp = H + (size_t)(row0 + ai * HALF + m * 16) * DEXP + col0;
                f32x4 h0, h1;
#pragma unroll
                for (int j = 0; j < 4; ++j) { const float a0 = acc[ai][0][m][0][j], a1 = acc[ai][0][m][1][j];
                    h0[j] = a0 * __builtin_amdgcn_rcpf(1.f + __builtin_amdgcn_exp2f(-1.4426950408889634f * a0)) * acc[ai][1][m][0][j];
                    h1[j] = a1 * __builtin_amdgcn_rcpf(1.f + __builtin_amdgcn_exp2f(-1.4426950408889634f * a1)) * acc[ai][1][m][1][j]; }
                pg8::u32x4 w; w.x = cvt_pk_bf16(h0[0], h0[1]); w.y = cvt_pk_bf16(h0[2], h0[3]); w.z = cvt_pk_bf16(h1[0], h1[1]); w.w = cvt_pk_bf16(h1[2], h1[3]);
                *(pg8::u32x4*)rowp = w; }
    }
};
struct EpiDown {
    static constexpr bool PERM = true;
    bf16* Y; const unsigned* list;
    __device__ __forceinline__ void operator()(const f32x4 (&acc)[2][2][4][2], const Unit& u, int wr, int wc, int fr, int fq) const {
        const int r0 = wr * 64 + fr, col0 = u.pn * BM + wc * 32 + 8 * fq;
#pragma unroll
        for (int ai = 0; ai < 2; ++ai)
#pragma unroll
            for (int m = 0; m < 4; ++m) { const int r = r0 + ai * HALF + m * 16;
                if (r < u.nv) { const unsigned li = list[u.aux + r]; const unsigned tok = li >> 1, k = li & 1u;
                    bf16* rowp = Y + ((size_t)k * MTOK + tok) * DM + col0;
#pragma unroll
                    for (int bj = 0; bj < 2; ++bj) { const f32x4 v0 = acc[ai][bj][m][0], v1 = acc[ai][bj][m][1];
                        pg8::u32x4 w; w.x = cvt_pk_bf16(v0[0], v0[1]); w.y = cvt_pk_bf16(v0[2], v0[3]); w.z = cvt_pk_bf16(v1[0], v1[1]); w.w = cvt_pk_bf16(v1[2], v1[3]);
                        *(pg8::u32x4*)(rowp + bj * HALF) = w; } } }
    }
};

struct MoeOrder {
    const LAS int* tab; const unsigned* list; int NT, G, c;
    __device__ __forceinline__ bool next(int i, Unit& u) const {
        const int T = __builtin_amdgcn_readfirstlane(tab[0]); const int L = i * G + c; if (L >= T * NT) return false;
        const int tile = L / NT, pn = L % NT; const int e = __builtin_amdgcn_readfirstlane(tab[64 + tile]); const int mt = tile - __builtin_amdgcn_readfirstlane(tab[1 + e]);
        u.pm = tile; u.pn = pn; u.pb = e * NT + pn; u.aux = e * MTOK + 256 * mt; u.nv = __builtin_amdgcn_readfirstlane(tab[256 + e]) - 256 * mt; return true;
    }
    __device__ __forceinline__ unsigned row_of(const Unit& u, int r) const { const int rr = r < u.nv ? r : u.nv - 1; return list[u.aux + rr] >> 1; }
    __device__ __forceinline__ void a_ready(const Unit&) const {}
    __device__ __forceinline__ void done(const Unit&) const {}
};
__device__ __forceinline__ void moe_plan(Frame& F) {
    LAS int* tab = (LAS int*)(F.lds + TAB_OFF);
    if (F.tid < NEXP) { int c = (int)__hip_atomic_load(F.ctl + CW_CNT + 64 * F.tid, RLX_AGENT); if (c > MTOK) c = MTOK; if (c < 0) c = 0; tab[256 + F.tid] = c; tab[320 + F.tid] = (c + 255) >> 8; }
    __syncthreads();
    if (F.tid == 0) { int s = 0; for (int e = 0; e < NEXP; ++e) { tab[1 + e] = s; s += tab[320 + e]; } if (s > HROWS / 256) s = HROWS / 256; tab[0] = s; }
    __syncthreads();
    if (F.tid < HROWS / 256) { int e = 0; for (int q = 0; q < NEXP; ++q) { if (F.tid >= tab[1 + q] && F.tid < tab[1 + q] + tab[320 + q]) e = q; } tab[64 + F.tid] = e; }
    __syncthreads();
}

__device__ __forceinline__ void p2_mixers(Frame& F) {
    const int gw = F.vcu * NWAVES + F.wave, NGW = F.G * NWAVES, lane = F.lane;
    const bf16* PA = (const bf16*)(F.ws + WS_PA); const bf16* MKV = (const bf16*)(F.ws + WS_MKV); bf16* AC = (bf16*)(F.ws + WS_ACAT);
    LAS float* pb = (LAS float*)(F.lds + RING_OFF + F.wave * 16384);
    { const float* wc = F.in[6];
      const size_t nitem = (size_t)MTOK * (CONV_DIM / 8);
      for (size_t it = (size_t)gw * 64 + lane; it < nitem; it += (size_t)NGW * 64) {
        const int tok = (int)(it / (CONV_DIM / 8)), c8 = (int)(it % (CONV_DIM / 8)) * 8, t = tok & (SEQ - 1);
        float accv[8];
#pragma unroll
        for (int j = 0; j < 8; ++j) accv[j] = 0.f;
#pragma unroll
        for (int d = 0; d < 3; ++d) { if (t - (2 - d) >= 0) { const bf16* rowp = PA + (size_t)(tok - (2 - d)) * NA;
            const v4u c4 = *(const v4u*)(rowp + PA_CC + c8), h4 = *(const v4u*)(rowp + PA_CH + c8);
            const unsigned cw[4] = {c4.x, c4.y, c4.z, c4.w}, hw[4] = {h4.x, h4.y, h4.z, h4.w};
#pragma unroll
            for (int q = 0; q < 4; ++q) { accv[2 * q] += wc[d * CONV_DIM + c8 + 2 * q] * (bflo(cw[q]) * bflo(hw[q])); accv[2 * q + 1] += wc[d * CONV_DIM + c8 + 2 * q + 1] * (bfhi(cw[q]) * bfhi(hw[q])); } } }
        const v4u b4 = *(const v4u*)(PA + (size_t)tok * NA + PA_CB + c8); const unsigned bw[4] = {b4.x, b4.y, b4.z, b4.w};
        v4u o; o.x = pk2(bflo(bw[0]) * accv[0], bfhi(bw[0]) * accv[1]); o.y = pk2(bflo(bw[1]) * accv[2], bfhi(bw[1]) * accv[3]); o.z = pk2(bflo(bw[2]) * accv[4], bfhi(bw[2]) * accv[5]); o.w = pk2(bflo(bw[3]) * accv[6], bfhi(bw[3]) * accv[7]);
        *(v4u*)(AC + (size_t)tok * KCAT + c8) = o; } }
    for (int it = gw; it < MTOK * 4; it += NGW) {
        const int tok = it >> 2, h = it & 3, t = tok & (SEQ - 1);
        float sc[7];
#pragma unroll
        for (int i = 0; i < 7; ++i) { const int kk = lane + 64 * i; float s = -INFINITY;
            if (kk < 387) { const int g = kk / 129, j = kk - 129 * g, dil = (g == 0) ? 1 : (g == 1 ? 4 : 16), pos = t - j * dil;
                if (pos >= 0) { const bf16* qp = PA + (size_t)tok * NA + PA_Q + g * 512 + h * 128; const bf16* kp = PA + (size_t)(tok - j * dil) * NA + PA_K + g * 512 + h * 128;
                    float d = 0.f;
#pragma unroll 4
                    for (int c = 0; c < 16; ++c) { const v4u qa = *(const v4u*)(qp + 8 * c), ka = *(const v4u*)(kp + 8 * c);
                        d += bflo(qa.x) * bflo(ka.x) + bfhi(qa.x) * bfhi(ka.x) + bflo(qa.y) * bflo(ka.y) + bfhi(qa.y) * bfhi(ka.y) + bflo(qa.z) * bflo(ka.z) + bfhi(qa.z) * bfhi(ka.z) + bflo(qa.w) * bflo(ka.w) + bfhi(qa.w) * bfhi(ka.w); }
                    const float slope = exp2f(-8.0f * (float)(g * 4 + h + 1) / 12.0f);
                    s = d * 0.08838834764831845f - slope * (float)(j * dil); } }
            sc[i] = s; }
        float mx = sc[0];
#pragma unroll
        for (int i = 1; i < 7; ++i) mx = fmaxf(mx, sc[i]);
        mx = wave_max(mx); float den = 0.f;
#pragma unroll
        for (int i = 0; i < 7; ++i) { sc[i] = (sc[i] == -INFINITY) ? 0.f : __expf(sc[i] - mx); den += sc[i]; }
        den = wave_sum(den); const float inv = 1.f / den;
#pragma unroll
        for (int i = 0; i < 7; ++i) pb[lane + 64 * i] = sc[i] * inv;
        LDS_WAIT(); asm volatile("" ::: "memory");
        float o0 = 0.f, o1 = 0.f;
        for (int g = 0; g < 3; ++g) { const int dil = (g == 0) ? 1 : (g == 1 ? 4 : 16); int jmax = t / dil; if (jmax > 128) jmax = 128;
            const bf16* vp = PA + (size_t)tok * NA + PA_V + g * 512 + h * 128 + 2 * lane;
            for (int j = 0; j <= jmax; ++j) { const float p = pb[129 * g + j]; const unsigned vv = *(const unsigned*)(vp - (size_t)(j * dil) * NA); o0 += p * bflo(vv); o1 += p * bfhi(vv); } }
        *(unsigned*)(AC + (size_t)tok * KCAT + 1024 + h * 128 + 2 * lane) = pk2(o0, o1);
        LDS_WAIT(); asm volatile("" ::: "memory");
    }
    for (int it = gw; it < MTOK * 4; it += NGW) {
        const int tok = it >> 2, h = it & 3, b = tok >> 11;
        const bf16* qp = PA + (size_t)tok * NA + PA_MQ + h * 256;
        float sc[4];
#pragma unroll
        for (int i = 0; i < 4; ++i) { const bf16* kp = MKV + (size_t)(b * MEM_LEN + lane + 64 * i) * (2 * MEM_DIM) + h * 256; float d = 0.f;
#pragma unroll 4
            for (int c = 0; c < 32; ++c) { const v4u qa = *(const v4u*)(qp + 8 * c), ka = *(const v4u*)(kp + 8 * c);
                d += bflo(qa.x) * bflo(ka.x) + bfhi(qa.x) * bfhi(ka.x) + bflo(qa.y) * bflo(ka.y) + bfhi(qa.y) * bfhi(ka.y) + bflo(qa.z) * bflo(ka.z) + bfhi(qa.z) * bfhi(ka.z) + bflo(qa.w) * bflo(ka.w) + bfhi(qa.w) * bfhi(ka.w); }
            sc[i] = d * 0.0625f; }
        float mx = fmaxf(fmaxf(sc[0], sc[1]), fmaxf(sc[2], sc[3])); mx = wave_max(mx); float den = 0.f;
#pragma unroll
        for (int i = 0; i < 4; ++i) { sc[i] = __expf(sc[i] - mx); den += sc[i]; }
        den = wave_sum(den); const float inv = 1.f / den;
#pragma unroll
        for (int i = 0; i < 4; ++i) pb[lane + 64 * i] = sc[i] * inv;
        LDS_WAIT(); asm volatile("" ::: "memory");
        float o[4] = {0.f, 0.f, 0.f, 0.f};
        const bf16* vp = MKV + (size_t)(b * MEM_LEN) * (2 * MEM_DIM) + MEM_DIM + h * 256 + 4 * lane;
        for (int m = 0; m < MEM_LEN; ++m) { const float p = pb[m]; const v2u vv = *(const v2u*)(vp + (size_t)m * (2 * MEM_DIM)); o[0] += p * bflo(vv.x); o[1] += p * bfhi(vv.x); o[2] += p * bflo(vv.y); o[3] += p * bfhi(vv.y); }
        v2u ov; ov.x = pk2(o[0], o[1]); ov.y = pk2(o[2], o[3]);
        *(v2u*)(AC + (size_t)tok * KCAT + 1536 + h * 256 + 4 * lane) = ov;
        LDS_WAIT(); asm volatile("" ::: "memory");
    }
}

__device__ __forceinline__ void p5_ln_route(Frame& F) {
    const int gw = F.vcu * NWAVES + F.wave, NGW = F.G * NWAVES, lane = F.lane;
    float* Y1 = F.out; bf16* X1B = (bf16*)(F.ws + WS_X1B); unsigned* list = (unsigned*)(F.ws + WS_LIST); float* tokw = (float*)(F.ws + WS_TOKW);
    const float* g1 = F.in[12]; const float* b1 = F.in[13]; const float* wg = F.in[14]; const float* bg = F.in[15]; const float* wrt = F.in[16]; const float* brt = F.in[17];
    for (int m = gw; m < MTOK; m += NGW) {
        GAS f32x4* xr = (GAS f32x4*)(Y1 + (size_t)m * DM) + lane; f32x4 v[8]; float s = 0.f;
#pragma unroll
        for (int j = 0; j < 8; ++j) { v[j] = xr[64 * j]; s += (v[j].x + v[j].y) + (v[j].z + v[j].w); }
        const float mean = wave_sum(s) * (1.f / DM); float s2 = 0.f;
#pragma unroll
        for (int j = 0; j < 8; ++j) { v[j] = v[j] - mean; s2 += (v[j].x * v[j].x + v[j].y * v[j].y) + (v[j].z * v[j].z + v[j].w * v[j].w); }
        const float rstd = 1.f / sqrtf(wave_sum(s2) * (1.f / DM) + LN_EPS);
        GAS v2u* o8 = (GAS v2u*)(X1B + (size_t)m * DM) + lane;
        float gl[4] = {0.f, 0.f, 0.f, 0.f};
#pragma unroll
        for (int j = 0; j < 8; ++j) { const f32x4 gg = ((const GAS f32x4*)g1)[lane + 64 * j], bb = ((const GAS f32x4*)b1)[lane + 64 * j]; v[j] = v[j] * rstd * gg + bb;
            xr[64 * j] = v[j]; v2u o; o.x = pk2(v[j].x, v[j].y); o.y = pk2(v[j].z, v[j].w); o8[64 * j] = o;
            const GAS f32x4* wp = (const GAS f32x4*)wg + 4 * (lane + 64 * j);
#pragma unroll
            for (int q = 0; q < 4; ++q) { const f32x4 w = wp[q]; const float xv = v[j][q]; gl[0] += xv * w.x; gl[1] += xv * w.y; gl[2] += xv * w.z; gl[3] += xv * w.w; } }
#pragma unroll
        for (int g = 0; g < 4; ++g) gl[g] = wave_sum(gl[g]) + bg[g];
        int gsel = 0; float gmax = gl[0];
#pragma unroll
        for (int g = 1; g < 4; ++g) if (gl[g] > gmax) { gmax = gl[g]; gsel = g; }
        float gden = 0.f;
#pragma unroll
        for (int g = 0; g < 4; ++g) gden += __expf(gl[g] - gmax);
        const float gwt = 1.f / gden;
        gsel = __builtin_amdgcn_readfirstlane(gsel);
        float el[8] = {0.f, 0.f, 0.f, 0.f, 0.f, 0.f, 0.f, 0.f};
        const GAS f32x4* wr4 = (const GAS f32x4*)(wrt + (size_t)gsel * DM * 8);
#pragma unroll
        for (int j = 0; j < 8; ++j)
#pragma unroll
            for (int q = 0; q < 4; ++q) { const int d = 4 * (lane + 64 * j) + q; const f32x4 wa = wr4[2 * d], wb = wr4[2 * d + 1]; const float xv = v[j][q];
                el[0] += xv * wa.x; el[1] += xv * wa.y; el[2] += xv * wa.z; el[3] += xv * wa.w; el[4] += xv * wb.x; el[5] += xv * wb.y; el[6] += xv * wb.z; el[7] += xv * wb.w; }
#pragma unroll
        for (int e = 0; e < 8; ++e) el[e] = wave_sum(el[e]) + brt[gsel * 8 + e];
        int i1 = 0; float v1 = el[0];
#pragma unroll
        for (int e = 1; e < 8; ++e) if (el[e] > v1) { v1 = el[e]; i1 = e; }
        int i2 = -1; float v2 = -INFINITY;
#pragma unroll
        for (int e = 0; e < 8; ++e) if (e != i1 && el[e] > v2) { v2 = el[e]; i2 = e; }
        const float e2 = __expf(v2 - v1), w1 = gwt / (1.f + e2), w2 = gwt * e2 / (1.f + e2);
        if (lane < 2) { const int ex = gsel * 8 + (lane == 0 ? i1 : i2); const unsigned slot = __hip_atomic_fetch_add(F.ctl + CW_CNT + 64 * ex, 1u, RLX_AGENT);
            if (slot < (unsigned)MTOK) list[(size_t)ex * MTOK + slot] = (unsigned)m * 2u + (unsigned)lane;
            tokw[2 * m + lane] = lane == 0 ? w1 : w2; }
    }
    LAS float* scr = (LAS float*)(F.lds + RING_OFF + F.wave * 16384);
    bf16* WGU = (bf16*)(F.ws + WS_WGU); bf16* WD = (bf16*)(F.ws + WS_WD);
    constexpr int IGU = (DM / 64) * (DEXP / 32), IDN = (DEXP / 64) * (DM / 32), IPE = 2 * IGU + IDN;
    for (int it = gw; it < NEXP * IPE; it += NGW) {
        const int e = it / IPE; int r = it % IPE;
        if (r < 2 * IGU) { const int up = r >= IGU; if (up) r -= IGU; const int nblk = DEXP / 32, kb = r / nblk, nb = r % nblk, n0 = 32 * nb;
            const float* W = (up ? F.in[19] : F.in[18]) + (size_t)e * DM * DEXP;
            transpose_item(W, DEXP, WGU, DM, (size_t)e * 1024 + 256 * (n0 >> 7) + (n0 & 127) + (up ? 128 : 0), 64 * kb, 64 * kb, n0, scr, lane); }
        else { r -= 2 * IGU; const int nblk = DM / 32, kb = r / nblk, nb = r % nblk;
            transpose_item(F.in[20] + (size_t)e * DEXP * DM, DM, WD, DEXP, (size_t)e * DM + 32 * nb, 64 * kb, 64 * kb, 32 * nb, scr, lane); }
    }
}

__device__ __forceinline__ void p8_final(Frame& F) {
    const int gw = F.vcu * NWAVES + F.wave, NGW = F.G * NWAVES, lane = F.lane;
    float* X1 = F.out; const bf16* Y = (const bf16*)(F.ws + WS_Y); const float* tokw = (const float*)(F.ws + WS_TOKW); const float* g2 = F.in[21]; const float* b2 = F.in[22];
    for (int m = gw; m < MTOK; m += NGW) {
        GAS f32x4* xr = (GAS f32x4*)(X1 + (size_t)m * DM) + lane; const GAS v2u* y0 = (const GAS v2u*)(Y + (size_t)m * DM) + lane; const GAS v2u* y1 = (const GAS v2u*)(Y + ((size_t)MTOK + m) * DM) + lane;
        const float w0 = tokw[2 * m], w1 = tokw[2 * m + 1];
        f32x4 v[8]; float s = 0.f;
#pragma unroll
        for (int j = 0; j < 8; ++j) { const f32x4 x = xr[64 * j]; const v2u a = y0[64 * j], b = y1[64 * j];
            f32x4 ya; ya.x = bflo(a.x); ya.y = bfhi(a.x); ya.z = bflo(a.y); ya.w = bfhi(a.y); f32x4 yb; yb.x = bflo(b.x); yb.y = bfhi(b.x); yb.z = bflo(b.y); yb.w = bfhi(b.y);
            v[j] = x * ALPHA + ya * w0 + yb * w1; s += (v[j].x + v[j].y) + (v[j].z + v[j].w); }
        const float mean = wave_sum(s) * (1.f / DM); float s2 = 0.f;
#pragma unroll
        for (int j = 0; j < 8; ++j) { v[j] = v[j] - mean; s2 += (v[j].x * v[j].x + v[j].y * v[j].y) + (v[j].z * v[j].z + v[j].w * v[j].w); }
        const float rstd = 1.f / sqrtf(wave_sum(s2) * (1.f / DM) + LN_EPS);
#pragma unroll
        for (int j = 0; j < 8; ++j) { const f32x4 gg = ((const GAS f32x4*)g2)[lane + 64 * j], bb = ((const GAS f32x4*)b2)[lane + 64 * j]; xr[64 * j] = v[j] * rstd * gg + bb; }
    }
}

struct Args { const float* in[23]; float* out; unsigned char* ws; int ph_lo, ph_hi, li, pad; };
__global__ void __launch_bounds__(NWAVES * 64, 2) fwd(Args args) {
    extern __shared__ __attribute__((aligned(16))) unsigned char lds[];
    Frame F;
    F.lds = (LAS unsigned char*)lds;
    F.MISC = (volatile LAS unsigned*)(F.lds + MISC_OFF);
    F.tid = threadIdx.x; F.lane = F.tid & 63; F.wave = __builtin_amdgcn_readfirstlane(F.tid >> 6);
    F.G = gridDim.x; { const int bx = blockIdx.x; F.vcu = (F.G % 8 == 0) ? (bx % 8) * (F.G / 8) + bx / 8 : bx; }
    F.ws = args.ws; F.ctl = (gu32*)(args.ws + WS_CTL); F.out = args.out;
#pragma unroll
    for (int i = 0; i < 23; ++i) F.in[i] = args.in[i];
    for (int u = F.tid; u < (LDS_BYTES - LDSCTL_OFF) / 4; u += NWAVES * 64) ((LAS unsigned*)(F.lds + LDSCTL_OFF))[u] = 0u;
    __syncthreads();
    XcdBarrier bar; bar.bar = (unsigned*)(F.ctl + CW_BAR); bar.x = 0; bar.st = nullptr;
    if (N_LAUNCHES == 1) bar = xcd_barrier_post((unsigned*)(F.ctl + CW_BAR), F.MISC + 8);
#define GRID_BAR() do { if (N_LAUNCHES == 1) xcd_barrier(bar); } while (0)
    const int lo = args.ph_lo, hi = args.ph_hi;
#define IN(k) (lo <= (k) && (k) < hi)
#define BOTH(k) (IN(k) && IN((k) + 1))
    unsigned char* ws = args.ws;
    const int bx = (int)blockIdx.x;

    if (IN(0)) { p0_prologue(F); if (BOTH(0)) GRID_BAR(); }

    if (IN(1)) {
        { pg8::Gemm g{(const bf16*)(ws + WS_XB), (const bf16*)(ws + WS_WIN), DM, DM, DM}; pg8::StaticOrder S; S.init(MTOK, IN_DIM, F.G, bx);
          EpiProj E{(bf16*)(ws + WS_PA), (bf16*)(ws + WS_GATES), F.in[5]};
          pg8::gemm_phase<EpiProj, pg8::StaticOrder, true, false>(F.lds + RING_OFF, g, S, E); }
        { pg8::Gemm g{(const bf16*)(ws + WS_MEMN), (const bf16*)(ws + WS_WKV), DM, DM, DM}; pg8::StaticOrder S; S.init(BATCH * MEM_LEN, 2 * MEM_DIM, F.G, (bx + F.G / 2) % F.G);
          EpiPlain E{(bf16*)(ws + WS_MKV), 2 * MEM_DIM};
          pg8::gemm_phase<EpiPlain, pg8::StaticOrder, true, false>(F.lds + RING_OFF, g, S, E); }
        if (BOTH(1)) GRID_BAR();
    }

    if (IN(2)) { p2_mixers(F); if (BOTH(2)) GRID_BAR(); }

    if (IN(3)) {
        const bf16* AC = (const bf16*)(ws + WS_ACAT); const bf16* WC = (const bf16*)(ws + WS_WCAT); const bf16* GT = (const bf16*)(ws + WS_GATES);
        float* macc = (float*)(ws + WS_MACC); bf16* merged = (bf16*)(ws + WS_MERGED);
        pg8::StaticOrder S; S.init(MTOK, DM, F.G, bx);
        { pg8::Gemm g{AC, WC, CONV_DIM, KCAT, KCAT}; EpiMerge<0> E{GT, macc, merged}; pg8::gemm_phase<EpiMerge<0>, pg8::StaticOrder, true, false>(F.lds + RING_OFF, g, S, E); }
        { pg8::Gemm g{AC + 1024, WC + 1024, DIL_OUT, KCAT, KCAT}; EpiMerge<1> E{GT, macc, merged}; pg8::gemm_phase<EpiMerge<1>, pg8::StaticOrder, true, false>(F.lds + RING_OFF, g, S, E); }
        { pg8::Gemm g{AC + 1536, WC + 1536, MEM_DIM, KCAT, KCAT}; EpiMerge<2> E{GT, macc, merged}; pg8::gemm_phase<EpiMerge<2>, pg8::StaticOrder, true, false>(F.lds + RING_OFF, g, S, E); }
        if (BOTH(3)) GRID_BAR();
    }

    if (IN(4)) {
        pg8::Gemm g{(const bf16*)(ws + WS_MERGED), (const bf16*)(ws + WS_WO), DM, DM, DM}; pg8::StaticOrder S; S.init(MTOK, DM, F.G, bx);
        EpiWo E{F.in[0], F.out};
        pg8::gemm_phase<EpiWo, pg8::StaticOrder, true, false>(F.lds + RING_OFF, g, S, E);
        if (BOTH(4)) GRID_BAR();
    }

    if (IN(5)) { p5_ln_route(F); if (BOTH(5)) GRID_BAR(); }

    if (IN(6)) {
        moe_plan(F);
        pg8::Gemm g{(const bf16*)(ws + WS_X1B), (const bf16*)(ws + WS_WGU), DM, DM, DM};
        MoeOrder S{(const LAS int*)(F.lds + TAB_OFF), (const unsigned*)(ws + WS_LIST), 4, F.G, bx};
        EpiGateUp E{(bf16*)(ws + WS_H)};
        pg8::gemm_phase<EpiGateUp, MoeOrder, true, true>(F.lds + RING_OFF, g, S, E);
        if (BOTH(6)) GRID_BAR();
    }

    if (IN(7)) {
        moe_plan(F);
        pg8::Gemm g{(const bf16*)(ws + WS_H), (const bf16*)(ws + WS_WD), DEXP, DEXP, DEXP};
        MoeOrder S{(const LAS int*)(F.lds + TAB_OFF), (const unsigned*)(ws + WS_LIST), 8, F.G, bx};
        EpiDown E{(bf16*)(ws + WS_Y), (const unsigned*)(ws + WS_LIST)};
        pg8::gemm_phase<EpiDown, MoeOrder, true, false>(F.lds + RING_OFF, g, S, E);
        if (BOTH(7)) GRID_BAR();
    }

    if (IN(8)) { p8_final(F); }
#undef IN
#undef BOTH
#undef GRID_BAR
}

extern "C" void kernel_launch(void* const* d_in, const int* in_sizes, int n_in, void* d_out, int out_size, void* d_ws, size_t ws_size, hipStream_t stream) {
    static int grid = 0;
    if (grid == 0) {
        if (n_in != 23 || in_sizes[0] != MTOK * DM || out_size != MTOK * DM || ws_size < WS_END) { fprintf(stderr, "kernel_launch: unexpected shapes/workspace (n_in %d, ws %zu); nothing launched\n", n_in, ws_size); grid = -1; return; }
        int dev = 0, cus = 0, per_cu = 0;
        if (hipGetDevice(&dev) != hipSuccess || hipDeviceGetAttribute(&cus, hipDeviceAttributeMultiprocessorCount, dev) != hipSuccess) { grid = -1; return; }
        if (hipFuncSetAttribute((const void*)fwd, hipFuncAttributeMaxDynamicSharedMemorySize, LDS_BYTES) != hipSuccess) { fprintf(stderr, "kernel_launch: hipFuncSetAttribute failed\n"); grid = -1; return; }
        if (hipOccupancyMaxActiveBlocksPerMultiprocessor(&per_cu, (const void*)fwd, NWAVES * 64, LDS_BYTES) != hipSuccess || per_cu < 1) fprintf(stderr, "kernel_launch: occupancy query reports %d\n", per_cu);
        (void)hipGetLastError();
        grid = cus;
    }
    if (grid < 0) return;
    if (hipMemsetAsync((char*)d_ws + WS_CTL, 0, CTL_ZERO_BYTES, stream) != hipSuccess) return;
    Args a{};
    for (int i = 0; i < 23; ++i) a.in[i] = (const float*)d_in[i];
    a.out = (float*)d_out; a.ws = (unsigned char*)d_ws;
    for (int li = 0; li < N_LAUNCHES; ++li) {
        a.ph_lo = (N_LAUNCHES == 1) ? 0 : li; a.ph_hi = (N_LAUNCHES == 1) ? N_PHASES : li + 1; a.li = li;
        hipLaunchKernelGGL(fwd, dim3(grid), dim3(NWAVES * 64), LDS_BYTES, stream, a);
        if (hipPeekAtLastError() != hipSuccess) { fprintf(stderr, "kernel_launch: launch %d failed\n", li); break; }
    }
}
```

```cpp
#include <hip/hip_runtime.h>
#include <cstdio>
#include <cstdint>

#ifndef MK_N_LAUNCHES
#define MK_N_LAUNCHES 1
#endif

namespace pg8 {
#define PG8_LAS __attribute__((address_space(3)))
typedef unsigned short bf16_t;
typedef short bf16x8 __attribute__((ext_vector_type(8)));
typedef float f32x4 __attribute__((ext_vector_type(4)));
typedef unsigned u32x4 __attribute__((ext_vector_type(4)));
typedef unsigned u32x2 __attribute__((ext_vector_type(2)));
constexpr int BM = 256, BK = 64, HALF = 128, HTB = HALF * BK * 2, STAGE_BYTES = 8 * HTB, NXCD = 8, WGM = 8;

__host__ __device__ __forceinline__ int lds_byte(int r, int c) { const int st = (r >> 4) * 2 + (c >> 5), rr = r & 15, cc = c & 31, ob = rr * 64 + cc * 2; return st * 1024 + (ob ^ (((ob >> 9) & 1) << 5)); }
__host__ __device__ __forceinline__ void stage_rc(int b, int& R, int& C) { const int st = b / 1024, sb = b % 1024, swz = sb ^ (((sb >> 9) & 1) << 5); R = (st >> 1) * 16 + swz / 64; C = (st & 1) * 32 + (swz % 64) / 2; }
__host__ __device__ __forceinline__ int perm32(int rho) { const int n = rho >> 4, i = rho & 15; return 8 * (i >> 2) + 4 * n + (i & 3); }

struct Unit { int pm, pn, pb, aux, nv; };
struct Gemm { const bf16_t* A; const bf16_t* Bt; int K, lda, ldb; };

struct StaticOrder {
    int nM, nN, nwg, G, c;
    __host__ __device__ void init(int M, int N, int G_, int c_) { nM = M / BM; nN = N / BM; nwg = nM * nN; G = G_; c = c_; }
    __host__ __device__ bool next(int i, Unit& u) const {
        const long L = (long)i * G + c; if (L >= nwg) return false;
        int wgid = (int)L; { const int q = nwg / NXCD, r = nwg % NXCD, xcd = wgid % NXCD, off = wgid / NXCD; wgid = (xcd < r ? xcd * (q + 1) : r * (q + 1) + (xcd - r) * q) + off; }
        const int nig = WGM * nN, gid = wgid / nig, fm = gid * WGM, gsz = (nM - fm) < WGM ? (nM - fm) : WGM;
        u.pm = fm + ((wgid % nig) % gsz); u.pn = (wgid % nig) / gsz; u.pb = u.pn; u.aux = 0; u.nv = 256; return true;
    }
    __device__ __forceinline__ unsigned row_of(const Unit&, int r) const { return (unsigned)r; }
    __device__ __forceinline__ void a_ready(const Unit&) const {}
    __device__ __forceinline__ void done(const Unit&) const {}
};

__device__ __forceinline__ unsigned cvt_pk_bf16(float lo, float hi) { unsigned r; asm volatile("v_cvt_pk_bf16_f32 %0, %1, %2" : "=v"(r) : "v"(lo), "v"(hi)); return r; }

template <class Epi, class Sched, bool ALIGN_EPI, bool GATHER>
__device__ __forceinline__ void gemm_phase(PG8_LAS unsigned char* lds, const Gemm g, const Sched& S, const Epi& E) {
    const int tid = threadIdx.x, wid = __builtin_amdgcn_readfirstlane(tid >> 6), lane = tid & 63, wr = wid >> 2, wc = wid & 3, fr = lane & 15, fq = lane >> 4;
    const int K = g.K, nt = K / BK;
    unsigned voffB[2], cvA0[2], cvA1[2], nvA0[2], nvA1[2]; int RA[2], CA[2];
#pragma unroll
    for (int i = 0; i < 2; ++i) { int R, C; stage_rc(tid * 16 + i * 8192, R, C); const int Rb = Epi::PERM ? ((R & ~31) + perm32(R & 31)) : R;
        RA[i] = R; CA[i] = C; voffB[i] = (unsigned)(Rb * g.ldb + C) * 2u; }
    const size_t kstep = (size_t)(BK * 2);
    const size_t hstepB = (size_t)HALF * g.ldb * 2, tstepB = 2 * hstepB, tstepA = (size_t)BM * g.lda * 2;
    const unsigned ldsw = (unsigned)wid * 1024u;
    const int aoff = lds_byte(wr * 64 + fr, fq * 8), boff = lds_byte(wc * 32 + fr, fq * 8);
#define PG8_SA(b, h) (((b) * 2 + (h)) * HTB)
#define PG8_SB(b, h) ((4 + (b) * 2 + (h)) * HTB)
#define PG8_STAGE(bufoff, gbase, voff) do { _Pragma("unroll") for (int _i = 0; _i < 2; ++_i) \
        __builtin_amdgcn_global_load_lds((const unsigned*)((const char*)(gbase) + (voff)[_i]), (PG8_LAS unsigned*)(lds + (bufoff) + ldsw + _i * 8192), 16, 0, 0); } while (0)
#define PG8_LDA(dst, b, h) do { _Pragma("unroll") for (int m = 0; m < 4; ++m) _Pragma("unroll") for (int k = 0; k < 2; ++k) dst[m][k] = *(const PG8_LAS bf16x8*)(lds + PG8_SA(b, h) + aoff + m * 2048 + k * 1024); } while (0)
#define PG8_LDB(dst, b, h) do { _Pragma("unroll") for (int n = 0; n < 2; ++n) _Pragma("unroll") for (int k = 0; k < 2; ++k) dst[n][k] = *(const PG8_LAS bf16x8*)(lds + PG8_SB(b, h) + boff + n * 2048 + k * 1024); } while (0)
#define PG8_MMA(ai, bj, At, Bt) do { __builtin_amdgcn_s_setprio(1); _Pragma("unroll") for (int m = 0; m < 4; ++m) _Pragma("unroll") for (int n = 0; n < 2; ++n) _Pragma("unroll") for (int k = 0; k < 2; ++k) \
        acc[ai][bj][m][n] = __builtin_amdgcn_mfma_f32_16x16x32_bf16(Bt[n][k], At[m][k], acc[ai][bj][m][n], 0, 0, 0); __builtin_amdgcn_s_setprio(0); } while (0)
#define PG8_WAIT_V(n) asm volatile("s_waitcnt vmcnt(" #n ")" ::: "memory")
#define PG8_WAIT_L(n) asm volatile("s_waitcnt lgkmcnt(" #n ")" ::: "memory")
#define PG8_BAR __builtin_amdgcn_s_barrier()
#define PG8_SCHED __builtin_amdgcn_sched_barrier(0)
#define PG8_ROWS(U, d0, d1) do { if constexpr (GATHER) { const unsigned _r0 = S.row_of(U, RA[0]), _r1 = S.row_of(U, RA[1]), _r2 = S.row_of(U, RA[0] + HALF), _r3 = S.row_of(U, RA[1] + HALF); \
        d0[0] = (_r0 * (unsigned)g.lda + (unsigned)CA[0]) * 2u; d0[1] = (_r1 * (unsigned)g.lda + (unsigned)CA[1]) * 2u; d1[0] = (_r2 * (unsigned)g.lda + (unsigned)CA[0]) * 2u; d1[1] = (_r3 * (unsigned)g.lda + (unsigned)CA[1]) * 2u; } \
      else { _Pragma("unroll") for (int _i = 0; _i < 2; ++_i) { d0[_i] = (unsigned)(RA[_i] * g.lda + CA[_i]) * 2u; d1[_i] = d0[_i] + (unsigned)(HALF * g.lda * 2); } } } while (0)
    Unit cur, nxt; int ui = 0;
    if (!S.next(0, cur)) return;
    f32x4 acc[2][2][4][2];
#pragma unroll
    for (int a = 0; a < 2; ++a)
#pragma unroll
        for (int b = 0; b < 2; ++b)
#pragma unroll
            for (int m = 0; m < 4; ++m)
#pragma unroll
                for (int n = 0; n < 2; ++n) acc[a][b][m][n] = (f32x4){0.f, 0.f, 0.f, 0.f};
    bf16x8 At[4][2], B0[2][2], B1[2][2];
    const char* cA = GATHER ? (const char*)g.A : (const char*)g.A + (size_t)cur.pm * tstepA; const char* cB = (const char*)g.Bt + (size_t)cur.pb * tstepB;
    S.a_ready(cur);
    PG8_ROWS(cur, cvA0, cvA1);
    PG8_STAGE(PG8_SB(0, 0), cB, voffB); PG8_STAGE(PG8_SB(0, 1), cB + hstepB, voffB); PG8_STAGE(PG8_SA(0, 0), cA, cvA0); PG8_STAGE(PG8_SA(0, 1), cA, cvA1);
    if (wr == 1) PG8_BAR;
    PG8_WAIT_V(2); PG8_BAR;
    PG8_STAGE(PG8_SB(1, 0), cB + kstep, voffB); PG8_STAGE(PG8_SA(1, 0), cA + kstep, cvA0); PG8_STAGE(PG8_SB(1, 1), cB + hstepB + kstep, voffB);
    PG8_WAIT_V(6); PG8_BAR;
    for (;;) {
        const bool has_next = S.next(ui + 1, nxt);
        const char* nA = has_next ? (GATHER ? (const char*)g.A : (const char*)g.A + (size_t)nxt.pm * tstepA) : cA; const char* nB = has_next ? (const char*)g.Bt + (size_t)nxt.pb * tstepB : cB;
#pragma unroll
        for (int i = 0; i < 2; ++i) { nvA0[i] = cvA0[i]; nvA1[i] = cvA1[i]; }
        for (int t = 0; t < nt; t += 2) {
            const bool last = (t == nt - 2);
            const char* a1 = cA + (size_t)(t + 1) * kstep;
            const char* a2 = last ? nA : cA + (size_t)(t + 2) * kstep; const char* b2 = last ? nB : cB + (size_t)(t + 2) * kstep;
            const char* a3 = a2 + kstep; const char* b3 = b2 + kstep;
            if (last && has_next) { S.a_ready(nxt); if constexpr (GATHER) { PG8_ROWS(nxt, nvA0, nvA1); } }
            unsigned xA0[2], xA1[2];
#pragma unroll
            for (int i = 0; i < 2; ++i) { xA0[i] = last ? nvA0[i] : cvA0[i]; xA1[i] = last ? nvA1[i] : cvA1[i]; }
            PG8_LDB(B0, 0, 0); PG8_LDB(B1, 0, 1); PG8_SCHED; PG8_LDA(At, 0, 0); PG8_STAGE(PG8_SA(1, 1), a1, cvA1);
            PG8_WAIT_V(8); PG8_WAIT_L(0); PG8_BAR; PG8_MMA(0, 0, At, B0); PG8_MMA(0, 1, At, B1); PG8_BAR; PG8_SCHED;
            PG8_LDA(At, 0, 1); PG8_STAGE(PG8_SB(0, 0), b2, voffB); PG8_STAGE(PG8_SB(0, 1), b2 + hstepB, voffB); PG8_STAGE(PG8_SA(0, 0), a2, xA0);
            PG8_WAIT_V(8); PG8_WAIT_L(0); PG8_BAR; PG8_MMA(1, 0, At, B0); PG8_MMA(1, 1, At, B1); PG8_BAR; PG8_SCHED;
            PG8_LDB(B0, 1, 0); PG8_LDB(B1, 1, 1); PG8_SCHED; PG8_LDA(At, 1, 0); PG8_STAGE(PG8_SA(0, 1), a2, xA1);
            PG8_WAIT_V(8); PG8_WAIT_L(0); PG8_BAR; PG8_MMA(0, 0, At, B0); PG8_MMA(0, 1, At, B1); PG8_BAR; PG8_SCHED;
            PG8_LDA(At, 1, 1); PG8_STAGE(PG8_SB(1, 0), b3, voffB); PG8_STAGE(PG8_SB(1, 1), b3 + hstepB, voffB); PG8_STAGE(PG8_SA(1, 0), a3, xA0);
            PG8_WAIT_V(8); PG8_WAIT_L(0); PG8_BAR; PG8_MMA(1, 0, At, B0); PG8_MMA(1, 1, At, B1); PG8_BAR; PG8_SCHED;
        }
        if constexpr (ALIGN_EPI) { if (wr == 0) PG8_BAR; }
        E(acc, cur, wr, wc, fr, fq); S.done(cur);
        if (!has_next) break;
#pragma unroll
        for (int a = 0; a < 2; ++a)
#pragma unroll
            for (int b = 0; b < 2; ++b)
#pragma unroll
                for (int m = 0; m < 4; ++m)
#pragma unroll
                    for (int n = 0; n < 2; ++n) acc[a][b][m][n] = (f32x4){0.f, 0.f, 0.f, 0.f};
        cur = nxt; cA = nA; cB = nB; ++ui;
#pragma unroll
        for (int i = 0; i < 2; ++i) { cvA0[i] = nvA0[i]; cvA1[i] = nvA1[i]; }
        if constexpr (ALIGN_EPI) { if (wr == 1) PG8_BAR; }
    }
    PG8_WAIT_V(0);
    if constexpr (!ALIGN_EPI) { if (wr == 0) PG8_BAR; }
    PG8_BAR;
#undef PG8_SA
#undef PG8_SB
#undef PG8_STAGE
#undef PG8_LDA
#undef PG8_LDB
#undef PG8_MMA
#undef PG8_WAIT_V
#undef PG8_WAIT_L
#undef PG8_BAR
#undef PG8_SCHED
#undef PG8_ROWS
}
}

constexpr int NWAVES = 8;
constexpr int N_LAUNCHES = MK_N_LAUNCHES;
constexpr int N_PHASES = 10;
constexpr int BATCH = 8, SEQ = 2048, DM = 2048, MTOK = BATCH * SEQ;
constexpr int CONV_DIM = 1024, DIL_DIM = 1536, DIL_OUT = 512, MEM_LEN = 256, MEM_DIM = 1024, IN_DIM = 14848;
constexpr int NA = 8704, NGATE = 6144, KCAT = 2560;
constexpr int PA_CB = 0, PA_CC = 1024, PA_CH = 2048, PA_Q = 3072, PA_K = 4608, PA_V = 6144, PA_MQ = 7680;
constexpr int NEXP = 32, DEXP = 512, HROWS = 40960;
constexpr float LN_EPS = 1e-5f;
constexpr float ALPHA = 1.189207115002721f;

constexpr size_t MiB = 1u << 20;
constexpr size_t WS_CTL = 0, CTL_ZERO_BYTES = 1 * MiB;
constexpr size_t WS_LIST = 1 * MiB, WS_TOKW = 3 * MiB;
constexpr size_t WS_WCAT = 8 * MiB, WS_WKV = 18 * MiB, WS_WO = 26 * MiB, WS_MEMN = 34 * MiB, WS_MKV = 42 * MiB;
constexpr size_t WS_WIN = 50 * MiB, WS_XB = 108 * MiB, WS_PA = 172 * MiB, WS_GATES = 444 * MiB, WS_END = 636 * MiB;
constexpr size_t WS_ACAT = 50 * MiB;
constexpr size_t WS_DILO = 130 * MiB;
constexpr size_t WS_LSE = 162 * MiB;
constexpr size_t WS_MACC = 172 * MiB;
constexpr size_t WS_MERGED = 300 * MiB;
constexpr size_t WS_X1B = 364 * MiB;
constexpr size_t WS_WGU = 444 * MiB;
constexpr size_t WS_WD = 572 * MiB;
constexpr size_t WS_H = 50 * MiB;
constexpr size_t WS_Y = 172 * MiB;
static_assert(WS_WIN + (size_t)IN_DIM * DM * 2 <= WS_XB && WS_XB + (size_t)MTOK * DM * 2 <= WS_PA && WS_PA + (size_t)MTOK * NA * 2 <= WS_GATES && WS_GATES + (size_t)MTOK * NGATE * 2 <= WS_END, "ws map");
static_assert(WS_ACAT + (size_t)MTOK * KCAT * 2 <= WS_PA && WS_MACC + (size_t)MTOK * DM * 4 <= WS_MERGED && WS_MERGED + (size_t)MTOK * DM * 2 <= WS_X1B && WS_X1B + (size_t)MTOK * DM * 2 <= WS_WGU, "ws map 2");
static_assert(WS_WGU + (size_t)NEXP * 1024 * DM * 2 <= WS_WD && WS_WD + (size_t)NEXP * DM * DEXP * 2 <= WS_END && WS_H + (size_t)HROWS * DEXP * 2 <= WS_PA && WS_Y + (size_t)2 * MTOK * DM * 2 <= WS_X1B, "ws map 3");

constexpr int CW_TMO = 0, CW_CODE = 1, CW_BAR = 4096, CW_CNT = 16384;

constexpr int RING_OFF = 0, RING_BYTES = 131072;
constexpr int LDSCTL_OFF = RING_BYTES, MISC_OFF = LDSCTL_OFF + 320, TAB_OFF = LDSCTL_OFF + 1024;
constexpr int LDS_BYTES = 147456;
static_assert(TAB_OFF + 2048 <= LDS_BYTES, "LDS map");

#define GAS __attribute__((address_space(1)))
#define LAS __attribute__((address_space(3)))
typedef unsigned short bf16;
typedef unsigned v4u __attribute__((ext_vector_type(4)));
typedef unsigned v2u __attribute__((ext_vector_type(2)));
typedef float f32x4 __attribute__((ext_vector_type(4)));
typedef GAS unsigned gu32;
#define RLX_AGENT __ATOMIC_RELAXED, __HIP_MEMORY_SCOPE_AGENT
#define LDS_WAIT() asm volatile("s_waitcnt lgkmcnt(0)" ::: "memory")
#define VM_WAIT() asm volatile("s_waitcnt vmcnt(0)" ::: "memory")
__device__ __forceinline__ unsigned f2bf(float f) { unsigned u = __builtin_bit_cast(unsigned, f); return (u + 0x7fffu + ((u >> 16) & 1u)) >> 16; }
__device__ __forceinline__ unsigned pk2(float lo, float hi) { return f2bf(lo) | (f2bf(hi) << 16); }
__device__ __forceinline__ float bflo(unsigned w) { return __builtin_bit_cast(float, w << 16); }
__device__ __forceinline__ float bfhi(unsigned w) { return __builtin_bit_cast(float, w & 0xffff0000u); }
__device__ __forceinline__ float bf1(bf16 b) { return __builtin_bit_cast(float, (unsigned)b << 16); }

#define XB_TMO      128
#define XB_XCNT(j)  (256  + 64 * (j))
#define XB_XSUB(j)  (1280 + 64 * (j))
#define XB_XGEN(j)  (2304 + 64 * (j))
#define XB_TOP      3328
#define XB_TOPGEN   3392
#define XCD_BAR_WORDS 3456
#define XB_SPIN_CAP (1u << 18)
__device__ __forceinline__ unsigned xb_ld(unsigned* p)              { return __hip_atomic_load(p, __ATOMIC_RELAXED, __HIP_MEMORY_SCOPE_AGENT); }
__device__ __forceinline__ unsigned xb_add(unsigned* p, unsigned v) { return __hip_atomic_fetch_add(p, v, __ATOMIC_RELAXED, __HIP_MEMORY_SCOPE_AGENT); }
__device__ __forceinline__ unsigned xb_xcc_id() { return (unsigned)__builtin_amdgcn_s_getreg((3 << 11) | 20) & 0xFu; }
#define XB_SPIN(cond, bar) do { unsigned _sp = 0; while (cond) { __builtin_amdgcn_s_sleep(1); \
    if ((++_sp & 255u) == 0u) { if (xb_ld(&(bar)[XB_TMO])) break; if (_sp > XB_SPIN_CAP) { atomicAdd(&(bar)[XB_TMO], 1u); break; } } } } while (0)
struct XcdBarrier { unsigned* bar; unsigned x; volatile LAS unsigned* st; };
__device__ __forceinline__ XcdBarrier xcd_barrier_post(unsigned* bar, volatile LAS unsigned* st) {
    XcdBarrier b; b.bar = bar; b.x = xb_xcc_id(); b.st = st;
    if (threadIdx.x == 0) (void)xb_add(&bar[XB_XCNT(b.x)], 1u);
    return b;
}
__device__ __forceinline__ void xcd_barrier_complete(unsigned* bar, unsigned x, unsigned& nloc, unsigned& nx) {
    const unsigned G = gridDim.x * gridDim.y * gridDim.z;
    unsigned sum, cnt, mine, sp = 0u;
    for (;;) {
        sum = 0u; cnt = 0u; mine = 0u;
#pragma unroll
        for (unsigned j = 0; j < 16; ++j) { const unsigned c = xb_ld(&bar[XB_XCNT(j)]); sum += c; cnt += (c > 0u) ? 1u : 0u; mine = (j == x) ? c : mine; }
        if (sum == G) break;
        __builtin_amdgcn_s_sleep(1);
        if ((++sp & 255u) == 0u) { if (xb_ld(&bar[XB_TMO])) break; if (sp > XB_SPIN_CAP) { atomicAdd(&bar[XB_TMO], 1u); break; } }
    }
    nloc = mine > 0u ? mine : 1u; nx = cnt > 0u ? cnt : 1u;
}
__device__ __forceinline__ void xcd_barrier(const XcdBarrier& b) {
    asm volatile("s_waitcnt vmcnt(0)" ::: "memory");
    __syncthreads();
    if (threadIdx.x == 0) {
        unsigned* bar = b.bar;
        __builtin_amdgcn_s_waitcnt(0);
        unsigned nloc = b.st[0], nx = b.st[1];
        if (nloc == 0u) { xcd_barrier_complete(bar, b.x, nloc, nx); b.st[0] = nloc; b.st[1] = nx; }
        const unsigned old = xb_add(&bar[XB_XSUB(b.x)], 1u);
        const unsigned gen = old / nloc;
        if (old + 1u == (gen + 1u) * nloc) {
            __builtin_amdgcn_fence(__ATOMIC_RELEASE, "agent");
            asm volatile("s_waitcnt vmcnt(0)" ::: "memory");
            const unsigned og = xb_add(&bar[XB_TOP], 1u);
            const unsigned tg = og / nx;
            if (og + 1u == (tg + 1u) * nx) xb_add(&bar[XB_TOPGEN], 1u);
            else XB_SPIN(xb_ld(&bar[XB_TOPGEN]) == tg, bar);
            __builtin_amdgcn_fence(__ATOMIC_ACQUIRE, "agent");
            xb_add(&bar[XB_XGEN(b.x)], 1u);
            asm volatile("s_waitcnt vmcnt(0)" ::: "memory");
        } else {
            XB_SPIN(xb_ld(&bar[XB_XGEN(b.x)]) == gen, bar);
            __builtin_amdgcn_fence(__ATOMIC_ACQUIRE, "agent");
            asm volatile("s_waitcnt vmcnt(0)" ::: "memory");
        }
    }
    __syncthreads();
}

struct Frame {
    LAS unsigned char* lds;
    volatile LAS unsigned* MISC;
    gu32* ctl;
    int tid, lane, wave;
    int vcu, G;
    unsigned char* ws;
    const float* in[23];
    float* out;
};

__device__ __forceinline__ float wave_sum(float v) {
#pragma unroll
    for (int o = 1; o < 64; o <<= 1) v += __shfl_xor(v, o);
    return v;
}
__device__ __forceinline__ float wave_max(float v) {
#pragma unroll
    for (int o = 1; o < 64; o <<= 1) v = fmaxf(v, __shfl_xor(v, o));
    return v;
}

__device__ __forceinline__ void transpose_item(const float* W, int N, bf16* WT, int ldt, size_t drow0, int dcol0, int k0, int n0, LAS float* scr, int lane) {
#pragma unroll 8
    for (int i = 0; i < 32; ++i) { const int kk = 2 * i + (lane >> 5); scr[kk * 33 + (lane & 31)] = W[(size_t)(k0 + kk) * N + n0 + (lane & 31)]; }
    LDS_WAIT(); asm volatile("" ::: "memory");
    const int c = lane & 7;
#pragma unroll
    for (int j = 0; j < 4; ++j) { const int n = (lane >> 3) + 8 * j; const LAS float* s = scr + (8 * c) * 33 + n;
        v4u o; o.x = pk2(s[0 * 33], s[1 * 33]); o.y = pk2(s[2 * 33], s[3 * 33]); o.z = pk2(s[4 * 33], s[5 * 33]); o.w = pk2(s[6 * 33], s[7 * 33]);
        *(GAS v4u*)(WT + (drow0 + n) * ldt + dcol0 + 8 * c) = o; }
    LDS_WAIT(); asm volatile("" ::: "memory");
}
__device__ __forceinline__ void transpose_matrix(Frame& F, LAS float* scr, const float* W, int K, int N, bf16* WT, int ldt, int dcol_base, int gw, int NGW) {
    const int nblk = N / 32, nitems = (K / 64) * nblk;
    for (int it = gw; it < nitems; it += NGW) { const int kb = it / nblk, nb = it % nblk; transpose_item(W, N, WT, ldt, (size_t)(32 * nb), dcol_base + 64 * kb, 64 * kb, 32 * nb, scr, F.lane); }
}

__device__ __forceinline__ void p0_prologue(Frame& F) {
    LAS float* scr = (LAS float*)(F.lds + RING_OFF + F.wave * 16384);
    const int gw = F.vcu * NWAVES + F.wave, NGW = F.G * NWAVES;
    unsigned char* ws = F.ws;
    transpose_matrix(F, scr, F.in[4], DM, IN_DIM, (bf16*)(ws + WS_WIN), DM, 0, gw, NGW);
    transpose_matrix(F, scr, F.in[7], CONV_DIM, DM, (bf16*)(ws + WS_WCAT), KCAT, 0, gw, NGW);
    transpose_matrix(F, scr, F.in[8], DIL_OUT, DM, (bf16*)(ws + WS_WCAT), KCAT, 1024, gw, NGW);
    transpose_matrix(F, scr, F.in[10], MEM_DIM, DM, (bf16*)(ws + WS_WCAT), KCAT, 1536, gw, NGW);
    transpose_matrix(F, scr, F.in[9], DM, 2 * MEM_DIM, (bf16*)(ws + WS_WKV), DM, 0, gw, NGW);
    transpose_matrix(F, scr, F.in[11], DM, DM, (bf16*)(ws + WS_WO), DM, 0, gw, NGW);
    { const GAS f32x4* x4 = (const GAS f32x4*)F.in[0]; GAS v4u* o4 = (GAS v4u*)(ws + WS_XB); const size_t n8 = (size_t)MTOK * DM / 8;
      for (size_t i = (size_t)gw * 64 + F.lane; i < n8; i += (size_t)NGW * 64) { const f32x4 a = x4[2 * i], b = x4[2 * i + 1]; v4u o; o.x = pk2(a.x, a.y); o.y = pk2(a.z, a.w); o.z = pk2(b.x, b.y); o.w = pk2(b.z, b.w); o4[i] = o; } }
    { const float* gm = F.in[2]; const float* bm = F.in[3]; bf16* mo = (bf16*)(ws + WS_MEMN);
      for (int m = gw; m < BATCH * MEM_LEN; m += NGW) {
        const GAS f32x4* xr = (const GAS f32x4*)(F.in[1] + (size_t)m * DM) + F.lane; f32x4 v[8]; float s = 0.f;
#pragma unroll
        for (int j = 0; j < 8; ++j) { v[j] = xr[64 * j]; s += (v[j].x + v[j].y) + (v[j].z + v[j].w); }
        const float mean = wave_sum(s) * (1.f / DM); float s2 = 0.f;
#pragma unroll
        for (int j = 0; j < 8; ++j) { v[j] = v[j] - mean; s2 += (v[j].x * v[j].x + v[j].y * v[j].y) + (v[j].z * v[j].z + v[j].w * v[j].w); }
        const float rstd = 1.f / sqrtf(wave_sum(s2) * (1.f / DM) + LN_EPS);
        GAS v2u* o8 = (GAS v2u*)(mo + (size_t)m * DM) + F.lane;
#pragma unroll
        for (int j = 0; j < 8; ++j) { const f32x4 gg = ((const GAS f32x4*)gm)[F.lane + 64 * j], bb = ((const GAS f32x4*)bm)[F.lane + 64 * j]; const f32x4 y = v[j] * rstd * gg + bb;
            v2u o; o.x = pk2(y.x, y.y); o.y = pk2(y.z, y.w); o8[64 * j] = o; }
      } }
}

using pg8::Unit; using pg8::cvt_pk_bf16; using pg8::HALF; using pg8::BM;
struct EpiProj {
    static constexpr bool PERM = true;
    bf16* PA; bf16* GT; const float* bias;
    __device__ __forceinline__ void operator()(const f32x4 (&acc)[2][2][4][2], const Unit& u, int wr, int wc, int fr, int fq) const {
        const int row0 = u.pm * BM + wr * 64 + fr; const bool isg = u.pn >= NA / 256;
        bf16* base = isg ? GT : PA; const int ldc = isg ? NGATE : NA; const int colt = isg ? (u.pn - NA / 256) * BM : u.pn * BM;
        const int col0 = colt + wc * 32 + 8 * fq, bcol0 = u.pn * BM + wc * 32 + 8 * fq;
        f32x4 bv[2][2];
#pragma unroll
        for (int bj = 0; bj < 2; ++bj)
#pragma unroll
            for (int n = 0; n < 2; ++n) bv[bj][n] = *(const f32x4*)(bias + bcol0 + bj * HALF + 4 * n);
#pragma unroll
        for (int ai = 0; ai < 2; ++ai)
#pragma unroll
            for (int m = 0; m < 4; ++m) { bf16* rowp = base + (size_t)(row0 + ai * HALF + m * 16) * ldc + col0;
#pragma unroll
                for (int bj = 0; bj < 2; ++bj) { f32x4 v0 = acc[ai][bj][m][0] + bv[bj][0], v1 = acc[ai][bj][m][1] + bv[bj][1];
                    if (isg) {
#pragma unroll
                        for (int j = 0; j < 4; ++j) { v0[j] = __builtin_amdgcn_rcpf(1.f + __builtin_amdgcn_exp2f(-1.4426950408889634f * v0[j])); v1[j] = __builtin_amdgcn_rcpf(1.f + __builtin_amdgcn_exp2f(-1.4426950408889634f * v1[j])); } }
                    pg8::u32x4 w; w.x = cvt_pk_bf16(v0[0], v0[1]); w.y = cvt_pk_bf16(v0[2], v0[3]); w.z = cvt_pk_bf16(v1[0], v1[1]); w.w = cvt_pk_bf16(v1[2], v1[3]);
                    *(pg8::u32x4*)(rowp + bj * HALF) = w; } }
    }
};
struct EpiPlain {
    static constexpr bool PERM = true;
    bf16* O; int ldc;
    __device__ __forceinline__ void operator()(const f32x4 (&acc)[2][2][4][2], const Unit& u, int wr, int wc, int fr, int fq) const {
        const int row0 = u.pm * BM + wr * 64 + fr, col0 = u.pn * BM + wc * 32 + 8 * fq;
#pragma unroll
        for (int ai = 0; ai < 2; ++ai)
#pragma unroll
            for (int m = 0; m < 4; ++m) { bf16* rowp = O + (size_t)(row0 + ai * HALF + m * 16) * ldc + col0;
#pragma unroll
                for (int bj = 0; bj < 2; ++bj) { const f32x4 v0 = acc[ai][bj][m][0], v1 = acc[ai][bj][m][1];
                    pg8::u32x4 w; w.x = cvt_pk_bf16(v0[0], v0[1]); w.y = cvt_pk_bf16(v0[2], v0[3]); w.z = cvt_pk_bf16(v1[0], v1[1]); w.w = cvt_pk_bf16(v1[2], v1[3]);
                    *(pg8::u32x4*)(rowp + bj * HALF) = w; } }
    }
};
template <int MODE> struct EpiMerge {
    static constexpr bool PERM = false;
    const bf16* GT; float* macc; bf16* merged;
    __device__ __forceinline__ void operator()(const f32x4 (&acc)[2][2][4][2], const Unit& u, int wr, int wc, int fr, int fq) const {
        const int row0 = u.pm * BM + wr * 64 + fr, col0 = u.pn * BM + wc * 32 + 4 * fq;
#pragma unroll
        for (int ai = 0; ai < 2; ++ai)
#pragma unroll
            for (int m = 0; m < 4; ++m) { const size_t row = (size_t)(row0 + ai * HALF + m * 16);
#pragma unroll
                for (int bj = 0; bj < 2; ++bj)
#pragma unroll
                    for (int n = 0; n < 2; ++n) { const int col = col0 + bj * HALF + n * 16;
                        const v2u gw = *(const v2u*)(GT + row * NGATE + MODE * DM + col);
                        f32x4 gv; gv.x = bflo(gw.x); gv.y = bfhi(gw.x); gv.z = bflo(gw.y); gv.w = bfhi(gw.y);
                        f32x4 r = gv * acc[ai][bj][m][n];
                        if (MODE > 0) r += *(const f32x4*)(macc + row * DM + col);
                        if (MODE < 2) *(f32x4*)(macc + row * DM + col) = r;
                        else { v2u o; o.x = cvt_pk_bf16(r.x, r.y); o.y = cvt_pk_bf16(r.z, r.w); *(v2u*)(merged + row * DM + col) = o; } } }
    }
};
struct EpiWo {
    static constexpr bool PERM = false;
    const float* x; float* y;
    __device__ __forceinline__ void operator()(const f32x4 (&acc)[2][2][4][2], const Unit& u, int wr, int wc, int fr, int fq) const {
        const int row0 = u.pm * BM + wr * 64 + fr, col0 = u.pn * BM + wc * 32 + 4 * fq;
#pragma unroll
        for (int ai = 0; ai < 2; ++ai)
#pragma unroll
            for (int m = 0; m < 4; ++m) { const size_t off = (size_t)(row0 + ai * HALF + m * 16) * DM + col0;
#pragma unroll
                for (int bj = 0; bj < 2; ++bj)
#pragma unroll
                    for (int n = 0; n < 2; ++n) { const f32x4 xv = *(const f32x4*)(x + off + bj * HALF + n * 16); *(f32x4*)(y + off + bj * HALF + n * 16) = xv * ALPHA + acc[ai][bj][m][n]; } }
    }
};
struct EpiGateUp {
    static constexpr bool PERM = true;
    bf16* H;
    __device__ __forceinline__ void operator()(const f32x4 (&acc)[2][2][4][2], const Unit& u, int wr, int wc, int fr, int fq) const {
        const int row0 = u.pm * BM + wr * 64 + fr, col0 = u.pn * HALF + wc * 32 + 8 * fq;
#pragma unroll
        for (int ai = 0; ai < 2; ++ai)
#pragma unroll
            for (int m = 0; m < 4; ++m) { bf16* rowp = H + (size_t)(row0 + ai * HALF + m * 16) * DEXP + col0;
                f32x4 h0, h1;
#pragma unroll
                for (int j = 0; j < 4; ++j) { const float a0 = acc[ai][0][m][0][j], a1 = acc[ai][0][m][1][j];
                    h0[j] = a0 * __builtin_amdgcn_rcpf(1.f + __builtin_amdgcn_exp2f(-1.4426950408889634f * a0)) * acc[ai][1][m][0][j];
                    h1[j] = a1 * __builtin_amdgcn_rcpf(1.f + __builtin_amdgcn_exp2f(-1.4426950408889634f * a1)) * acc[ai][1][m][1][j]; }
                pg8::u32x4 w; w.x = cvt_pk_bf16(h0[0], h0[1]); w.y = cvt_pk_bf16(h0[2], h0[3]); w.z = cvt_pk_bf16(h1[0], h1[1]); w.w = cvt_pk_bf16(h1[2], h1[3]);
                *(pg8::u32x4*)rowp = w; }
    }
};
struct EpiDown {
    static constexpr bool PERM = true;
    bf16* Y; const unsigned* list;
    __device__ __forceinline__ void operator()(const f32x4 (&acc)[2][2][4][2], const Unit& u, int wr, int wc, int fr, int fq) const {
        const int r0 = wr * 64 + fr, col0 = u.pn * BM + wc * 32 + 8 * fq;
#pragma unroll
        for (int ai = 0; ai < 2; ++ai)
#pragma unroll
            for (int m = 0; m < 4; ++m) { const int r = r0 + ai * HALF + m * 16;
                if (r < u.nv) { const unsigned li = list[u.aux + r]; const unsigned tok = li >> 1, k = li & 1u;
                    bf16* rowp = Y + ((size_t)k * MTOK + tok) * DM + col0;
#pragma unroll
                    for (int bj = 0; bj < 2; ++bj) { const f32x4 v0 = acc[ai][bj][m][0], v1 = acc[ai][bj][m][1];
                        pg8::u32x4 w; w.x = cvt_pk_bf16(v0[0], v0[1]); w.y = cvt_pk_bf16(v0[2], v0[3]); w.z = cvt_pk_bf16(v1[0], v1[1]); w.w = cvt_pk_bf16(v1[2], v1[3]);
                        *(pg8::u32x4*)(rowp + bj * HALF) = w; } } }
    }
};

struct MoeOrder {
    const LAS int* tab; const unsigned* list; int NT, G, c;
    __device__ __forceinline__ bool next(int i, Unit& u) const {
        const int T = __builtin_amdgcn_readfirstlane(tab[0]); const int L = i * G + c; if (L >= T * NT) return false;
        const int tile = L / NT, pn = L % NT; const int e = __builtin_amdgcn_readfirstlane(tab[64 + tile]); const int mt = tile - __builtin_amdgcn_readfirstlane(tab[1 + e]);
        u.pm = tile; u.pn = pn; u.pb = e * NT + pn; u.aux = e * MTOK + 256 * mt; u.nv = __builtin_amdgcn_readfirstlane(tab[256 + e]) - 256 * mt; return true;
    }
    __device__ __forceinline__ unsigned row_of(const Unit& u, int r) const { const int rr = r < u.nv ? r : u.nv - 1; return list[u.aux + rr] >> 1; }
    __device__ __forceinline__ void a_ready(const Unit&) const {}
    __device__ __forceinline__ void done(const Unit&) const {}
};
__device__ __forceinline__ void moe_plan(Frame& F) {
    LAS int* tab = (LAS int*)(F.lds + TAB_OFF);
    if (F.tid < NEXP) { int c = (int)__hip_atomic_load(F.ctl + CW_CNT + 64 * F.tid, RLX_AGENT); if (c > MTOK) c = MTOK; if (c < 0) c = 0; tab[256 + F.tid] = c; tab[320 + F.tid] = (c + 255) >> 8; }
    __syncthreads();
    if (F.tid == 0) { int s = 0; for (int e = 0; e < NEXP; ++e) { tab[1 + e] = s; s += tab[320 + e]; } if (s > HROWS / 256) s = HROWS / 256; tab[0] = s; }
    __syncthreads();
    if (F.tid < HROWS / 256) { int e = 0; for (int q = 0; q < NEXP; ++q) { if (F.tid >= tab[1 + q] && F.tid < tab[1 + q] + tab[320 + q]) e = q; } tab[64 + F.tid] = e; }
    __syncthreads();
}

typedef short s16x4 __attribute__((ext_vector_type(4)));
typedef short v4i16_t __attribute__((ext_vector_type(4)));
typedef short bf16x8v __attribute__((ext_vector_type(8)));
__device__ __forceinline__ s16x4 vtr(const LAS unsigned char* p) { return __builtin_bit_cast(s16x4, __builtin_amdgcn_ds_read_tr16_b64_v4i16((LAS v4i16_t*)p)); }
__device__ __forceinline__ bf16x8v cat8(s16x4 lo, s16x4 hi) { bf16x8v r; r[0] = lo[0]; r[1] = lo[1]; r[2] = lo[2]; r[3] = lo[3]; r[4] = hi[0]; r[5] = hi[1]; r[6] = hi[2]; r[7] = hi[3]; return r; }
__device__ __forceinline__ bf16x8v pack8(const f32x4& a, const f32x4& b) { v4u w; w.x = cvt_pk_bf16(a[0], a[1]); w.y = cvt_pk_bf16(a[2], a[3]); w.z = cvt_pk_bf16(b[0], b[1]); w.w = cvt_pk_bf16(b[2], b[3]); return __builtin_bit_cast(bf16x8v, w); }
constexpr float LOG2E = 1.4426950408889634f, LN2 = 0.6931471805599453f;

__device__ __forceinline__ void dil_unit(Frame& F, int g, int b, int h, int r, int n) {
    int tid = F.tid; asm volatile("" : "+v"(tid));
    const int lane = tid & 63, w = F.wave, l15 = lane & 15, gq = lane >> 4;
    const int d = g == 0 ? 1 : (g == 1 ? 4 : 16);
    const bf16* PA = (const bf16*)(F.ws + WS_PA);
    const size_t tok0 = (size_t)b * SEQ + r;
    LAS unsigned char* Kt = F.lds + RING_OFF; LAS unsigned char* Vt = F.lds + RING_OFF + 65536;
    const int colq = PA_Q + g * 512 + h * 128, colk = PA_K + g * 512 + h * 128, colv = PA_V + g * 512 + h * 128;
    { const int nrow0 = (n > 0) ? 0 : 128;
      const __amdgpu_buffer_rsrc_t rs = __builtin_amdgcn_make_buffer_rsrc((void*)(PA + (tok0 + (size_t)(128 * (n - 1) + nrow0) * d) * NA), (short)0, 0x7fffff00, 0x00020000);
      const int rstride = d * NA * 2; const int voff = (tid >> 4) * rstride + 16 * (tid & 15); const int r0 = tid >> 4, ch = tid & 15;
      LAS unsigned char* kw = Kt + r0 * 256 + ((ch ^ (r0 & 15)) << 4); LAS unsigned char* vw = Vt + r0 * 256 + ((ch ^ (2 * (r0 & 7))) << 4);
#pragma unroll
      for (int c = 0; c < 8; ++c) { v4u kv = (v4u){0u, 0u, 0u, 0u}, vv = (v4u){0u, 0u, 0u, 0u};
        if (n > 0 || c >= 4) { const int soff = (32 * c - nrow0) * rstride; kv = __builtin_amdgcn_raw_buffer_load_b128(rs, voff + colk * 2, soff, 0); vv = __builtin_amdgcn_raw_buffer_load_b128(rs, voff + colv * 2, soff, 0); }
        *(LAS v4u*)(kw + 8192 * c) = kv; *(LAS v4u*)(vw + 8192 * c) = vv; } }
    const int qi = 16 * w + l15; const size_t qtok = tok0 + (size_t)(128 * n + qi) * d;
    bf16x8v qf[4];
#pragma unroll
    for (int ks = 0; ks < 4; ++ks) qf[ks] = *(const bf16x8v*)(PA + qtok * NA + colq + 32 * ks + 8 * gq);
    __syncthreads();
    f32x4 st[10];
#pragma unroll
    for (int bi = 0; bi < 10; ++bi) { const int blk = (w + bi) < 15 ? (w + bi) : 15; const int row = 16 * blk + l15; f32x4 a = (f32x4){0.f, 0.f, 0.f, 0.f};
#pragma unroll
        for (int ks = 0; ks < 4; ++ks) { const bf16x8v kf = *(const LAS bf16x8v*)(Kt + row * 256 + (((4 * ks + gq) ^ l15) << 4)); a = __builtin_amdgcn_mfma_f32_16x16x32_bf16(kf, qf[ks], a, 0, 0, 0); }
        st[bi] = a; }
    const float slope = exp2f(-8.0f * (float)(g * 4 + h + 1) / 12.0f);
    const float c2 = slope * (float)d * LOG2E, sc2 = 0.08838834764831845f * LOG2E;
    float mx = -INFINITY;
#pragma unroll
    for (int bi = 0; bi < 10; ++bi)
#pragma unroll
        for (int q = 0; q < 4; ++q) { const int kj = 16 * (w + bi) + 4 * gq + q, jrel = qi + 128 - kj; const bool valid = (jrel >= 0) && (jrel <= 128) && (n > 0 || kj >= 128);
            const float s = valid ? st[bi][q] * sc2 - c2 * (float)jrel : -INFINITY; st[bi][q] = s; mx = fmaxf(mx, s); }
    mx = fmaxf(mx, __shfl_xor(mx, 16)); mx = fmaxf(mx, __shfl_xor(mx, 32));
    float lsum = 0.f;
#pragma unroll
    for (int bi = 0; bi < 10; ++bi)
#pragma unroll
        for (int q = 0; q < 4; ++q) { const float p = __builtin_amdgcn_exp2f(st[bi][q] - mx); st[bi][q] = p; lsum += p; }
    lsum += __shfl_xor(lsum, 16); lsum += __shfl_xor(lsum, 32);
    bf16x8v pf[5];
#pragma unroll
    for (int s = 0; s < 5; ++s) pf[s] = pack8(st[2 * s], st[2 * s + 1]);
    const float inv = 1.f / lsum;
    bf16* outp; int ldo;
    if (g == 0) { outp = (bf16*)(F.ws + WS_ACAT) + qtok * KCAT + 1024 + h * 128; ldo = KCAT; } else { outp = (bf16*)(F.ws + WS_DILO) + ((size_t)(g - 1) * MTOK + qtok) * DIL_OUT + h * 128; ldo = DIL_OUT; }
    (void)ldo;
    const int tq = l15 >> 2, tp = l15 & 3;
#pragma unroll 1
    for (int db = 0; db < 8; ++db) { f32x4 o = (f32x4){0.f, 0.f, 0.f, 0.f};
#pragma unroll
        for (int s = 0; s < 5; ++s) { const int b0 = (w + 2 * s) < 15 ? (w + 2 * s) : 15, b1 = (w + 2 * s + 1) < 15 ? (w + 2 * s + 1) : 15;
            const int r0 = 16 * b0 + 4 * gq + tq, r1 = 16 * b1 + 4 * gq + tq; const int sw = 2 * ((4 * gq + tq) & 7);
            const s16x4 lo = vtr(Vt + r0 * 256 + (((2 * db + (tp >> 1)) ^ sw) << 4) + 8 * (tp & 1)), hi = vtr(Vt + r1 * 256 + (((2 * db + (tp >> 1)) ^ sw) << 4) + 8 * (tp & 1));
            o = __builtin_amdgcn_mfma_f32_16x16x32_bf16(cat8(lo, hi), pf[s], o, 0, 0, 0); }
        v2u ov; ov.x = cvt_pk_bf16(o[0] * inv, o[1] * inv); ov.y = cvt_pk_bf16(o[2] * inv, o[3] * inv);
        *(v2u*)(outp + 16 * db + 4 * gq) = ov; }
    if (gq == 0) ((float*)(F.ws + WS_LSE))[((size_t)g * MTOK + qtok) * 4 + h] = (mx + __builtin_amdgcn_logf(lsum)) * LN2;
    __syncthreads();
}
__device__ __forceinline__ void mem_unit(Frame& F, int b, int h, int qb) {
    int tid = F.tid; asm volatile("" : "+v"(tid));
    const int lane = tid & 63, w = F.wave, l15 = lane & 15, gq = lane >> 4;
    const bf16* PA = (const bf16*)(F.ws + WS_PA); const bf16* MKV = (const bf16*)(F.ws + WS_MKV);
    LAS unsigned char* T = F.lds + RING_OFF;
    const bf16* kvb = MKV + (size_t)(b * MEM_LEN) * (2 * MEM_DIM) + h * 256;
    const __amdgpu_buffer_rsrc_t rs = __builtin_amdgcn_make_buffer_rsrc((void*)kvb, (short)0, 0x7fffff00, 0x00020000);
    const int r0 = tid >> 5, ch = tid & 31, voff = r0 * (2 * MEM_DIM * 2) + 16 * ch;
    { LAS unsigned char* kw = T + r0 * 512 + ((ch ^ (r0 & 15)) << 4);
#pragma unroll
      for (int c = 0; c < 16; ++c) { const v4u kv = __builtin_amdgcn_raw_buffer_load_b128(rs, voff, c * 16 * (2 * MEM_DIM * 2), 0); *(LAS v4u*)(kw + 8192 * c) = kv; } }
    const size_t qtok = (size_t)b * SEQ + 128 * qb + 16 * w + l15;
    bf16x8v qf[8];
#pragma unroll
    for (int ks = 0; ks < 8; ++ks) qf[ks] = *(const bf16x8v*)(PA + qtok * NA + PA_MQ + h * 256 + 32 * ks + 8 * gq);
    __syncthreads();
    f32x4 st[16];
#pragma unroll
    for (int bi = 0; bi < 16; ++bi) { const int row = 16 * bi + l15; f32x4 a = (f32x4){0.f, 0.f, 0.f, 0.f};
#pragma unroll
        for (int ks = 0; ks < 8; ++ks) { const bf16x8v kf = *(const LAS bf16x8v*)(T + row * 512 + (((4 * ks + gq) ^ l15) << 4)); a = __builtin_amdgcn_mfma_f32_16x16x32_bf16(kf, qf[ks], a, 0, 0, 0); }
        st[bi] = a; }
    const float sc2 = 0.0625f * LOG2E;
    float mx = -INFINITY;
#pragma unroll
    for (int bi = 0; bi < 16; ++bi)
#pragma unroll
        for (int q = 0; q < 4; ++q) { st[bi][q] *= sc2; mx = fmaxf(mx, st[bi][q]); }
    mx = fmaxf(mx, __shfl_xor(mx, 16)); mx = fmaxf(mx, __shfl_xor(mx, 32));
    float lsum = 0.f;
#pragma unroll
    for (int bi = 0; bi < 16; ++bi)
#pragma unroll
        for (int q = 0; q < 4; ++q) { const float p = __builtin_amdgcn_exp2f(st[bi][q] - mx); st[bi][q] = p; lsum += p; }
    lsum += __shfl_xor(lsum, 16); lsum += __shfl_xor(lsum, 32);
    bf16x8v pf[8];
#pragma unroll
    for (int s = 0; s < 8; ++s) pf[s] = pack8(st[2 * s], st[2 * s + 1]);
    const float inv = 1.f / lsum;
    __syncthreads();
    { LAS unsigned char* vw = T + r0 * 512 + ((ch ^ (2 * (r0 & 7))) << 4);
#pragma unroll
      for (int c = 0; c < 16; ++c) { const v4u vv = __builtin_amdgcn_raw_buffer_load_b128(rs, voff + MEM_DIM * 2, c * 16 * (2 * MEM_DIM * 2), 0); *(LAS v4u*)(vw + 8192 * c) = vv; } }
    __syncthreads();
    bf16* outp = (bf16*)(F.ws + WS_ACAT) + qtok * KCAT + 1536 + h * 256;
    const int tq = l15 >> 2, tp = l15 & 3;
#pragma unroll 1
    for (int db = 0; db < 16; ++db) { f32x4 o = (f32x4){0.f, 0.f, 0.f, 0.f};
#pragma unroll
        for (int s = 0; s < 8; ++s) { const int r0 = 32 * s + 4 * gq + tq, r1 = r0 + 16; const int sw = 2 * ((4 * gq + tq) & 7);
            const s16x4 lo = vtr(T + r0 * 512 + (((2 * db + (tp >> 1)) ^ sw) << 4) + 8 * (tp & 1)), hi = vtr(T + r1 * 512 + (((2 * db + (tp >> 1)) ^ sw) << 4) + 8 * (tp & 1));
            o = __builtin_amdgcn_mfma_f32_16x16x32_bf16(cat8(lo, hi), pf[s], o, 0, 0, 0); }
        v2u ov; ov.x = cvt_pk_bf16(o[0] * inv, o[1] * inv); ov.y = cvt_pk_bf16(o[2] * inv, o[3] * inv);
        *(v2u*)(outp + 16 * db + 4 * gq) = ov; }
    __syncthreads();
}
__device__ __forceinline__ void p2_attention(Frame& F) {
    const int c = F.vcu, G = F.G;
    for (int L = c; L < 2048; L += G) {
        if (L < 1536) { const int g = L >> 9, x = L & 511, b = x >> 6, h = (x >> 4) & 3;
            if (g == 0) dil_unit(F, 0, b, h, 0, x & 15); else if (g == 1) dil_unit(F, 1, b, h, (x >> 2) & 3, x & 3); else dil_unit(F, 2, b, h, x & 15, 0); }
        else { const int x = L - 1536; mem_unit(F, x >> 6, (x >> 4) & 3, x & 15); }
    }
}
__device__ __forceinline__ void p3_conv_combine(Frame& F) {
    const int gw = F.vcu * NWAVES + F.wave, NGW = F.G * NWAVES, lane = F.lane;
    const bf16* PA = (const bf16*)(F.ws + WS_PA); bf16* AC = (bf16*)(F.ws + WS_ACAT);
    { const float* wc = F.in[6];
      const size_t nitem = (size_t)MTOK * (CONV_DIM / 8);
      for (size_t it = (size_t)gw * 64 + lane; it < nitem; it += (size_t)NGW * 64) {
        const int tok = (int)(it / (CONV_DIM / 8)), c8 = (int)(it % (CONV_DIM / 8)) * 8, t = tok & (SEQ - 1);
        float accv[8];
#pragma unroll
        for (int j = 0; j < 8; ++j) accv[j] = 0.f;
#pragma unroll
        for (int d = 0; d < 3; ++d) { if (t - (2 - d) >= 0) { const bf16* rowp = PA + (size_t)(tok - (2 - d)) * NA;
            const v4u c4 = *(const v4u*)(rowp + PA_CC + c8), h4 = *(const v4u*)(rowp + PA_CH + c8);
            const unsigned cw[4] = {c4.x, c4.y, c4.z, c4.w}, hw[4] = {h4.x, h4.y, h4.z, h4.w};
#pragma unroll
            for (int q = 0; q < 4; ++q) { accv[2 * q] += wc[d * CONV_DIM + c8 + 2 * q] * (bflo(cw[q]) * bflo(hw[q])); accv[2 * q + 1] += wc[d * CONV_DIM + c8 + 2 * q + 1] * (bfhi(cw[q]) * bfhi(hw[q])); } } }
        const v4u b4 = *(const v4u*)(PA + (size_t)tok * NA + PA_CB + c8); const unsigned bw[4] = {b4.x, b4.y, b4.z, b4.w};
        v4u o; o.x = pk2(bflo(bw[0]) * accv[0], bfhi(bw[0]) * accv[1]); o.y = pk2(bflo(bw[1]) * accv[2], bfhi(bw[1]) * accv[3]); o.z = pk2(bflo(bw[2]) * accv[4], bfhi(bw[2]) * accv[5]); o.w = pk2(bflo(bw[3]) * accv[6], bfhi(bw[3]) * accv[7]);
        *(v4u*)(AC + (size_t)tok * KCAT + c8) = o; } }
    { const bf16* DO = (const bf16*)(F.ws + WS_DILO); const float* LSE = (const float*)(F.ws + WS_LSE);
      const size_t nitem = (size_t)MTOK * (DIL_OUT / 8);
      for (size_t it = (size_t)gw * 64 + lane; it < nitem; it += (size_t)NGW * 64) {
        const size_t tok = it / (DIL_OUT / 8); const int c8 = (int)(it % (DIL_OUT / 8)) * 8, h = c8 >> 7;
        const float l0 = LSE[tok * 4 + h], l1 = LSE[((size_t)MTOK + tok) * 4 + h], l2 = LSE[((size_t)2 * MTOK + tok) * 4 + h];
        const float m = fmaxf(l0, fmaxf(l1, l2)); float w0 = __expf(l0 - m), w1 = __expf(l1 - m), w2 = __expf(l2 - m); const float iw = 1.f / (w0 + w1 + w2); w0 *= iw; w1 *= iw; w2 *= iw;
        bf16* op = AC + tok * KCAT + 1024 + c8;
        const v4u a = *(const v4u*)op, bb = *(const v4u*)(DO + tok * DIL_OUT + c8), cc = *(const v4u*)(DO + ((size_t)MTOK + tok) * DIL_OUT + c8);
        const unsigned aw[4] = {a.x, a.y, a.z, a.w}, bw[4] = {bb.x, bb.y, bb.z, bb.w}, cw[4] = {cc.x, cc.y, cc.z, cc.w}; unsigned ow[4];
#pragma unroll
        for (int q = 0; q < 4; ++q) ow[q] = pk2(w0 * bflo(aw[q]) + w1 * bflo(bw[q]) + w2 * bflo(cw[q]), w0 * bfhi(aw[q]) + w1 * bfhi(bw[q]) + w2 * bfhi(cw[q]));
        *(v4u*)op = (v4u){ow[0], ow[1], ow[2], ow[3]}; } }
}

__device__ __forceinline__ void p5_ln_route(Frame& F) {
    const int gw = F.vcu * NWAVES + F.wave, NGW = F.G * NWAVES, lane = F.lane;
    float* Y1 = F.out; bf16* X1B = (bf16*)(F.ws + WS_X1B); unsigned* list = (unsigned*)(F.ws + WS_LIST); float* tokw = (float*)(F.ws + WS_TOKW);
    const float* g1 = F.in[12]; const float* b1 = F.in[13]; const float* wg = F.in[14]; const float* bg = F.in[15]; const float* wrt = F.in[16]; const float* brt = F.in[17];
    for (int m = gw; m < MTOK; m += NGW) {
        GAS f32x4* xr = (GAS f32x4*)(Y1 + (size_t)m * DM) + lane; f32x4 v[8]; float s = 0.f;
#pragma unroll
        for (int j = 0; j < 8; ++j) { v[j] = xr[64 * j]; s += (v[j].x + v[j].y) + (v[j].z + v[j].w); }
        const float mean = wave_sum(s) * (1.f / DM); float s2 = 0.f;
#pragma unroll
        for (int j = 0; j < 8; ++j) { v[j] = v[j] - mean; s2 += (v[j].x * v[j].x + v[j].y * v[j].y) + (v[j].z * v[j].z + v[j].w * v[j].w); }
        const float rstd = 1.f / sqrtf(wave_sum(s2) * (1.f / DM) + LN_EPS);
        GAS v2u* o8 = (GAS v2u*)(X1B + (size_t)m * DM) + lane;
        float gl[4] = {0.f, 0.f, 0.f, 0.f};
#pragma unroll
        for (int j = 0; j < 8; ++j) { const f32x4 gg = ((const GAS f32x4*)g1)[lane + 64 * j], bb = ((const GAS f32x4*)b1)[lane + 64 * j]; v[j] = v[j] * rstd * gg + bb;
            xr[64 * j] = v[j]; v2u o; o.x = pk2(v[j].x, v[j].y); o.y = pk2(v[j].z, v[j].w); o8[64 * j] = o;
            const GAS f32x4* wp = (const GAS f32x4*)wg + 4 * (lane + 64 * j);
#pragma unroll
            for (int q = 0; q < 4; ++q) { const f32x4 w = wp[q]; const float xv = v[j][q]; gl[0] += xv * w.x; gl[1] += xv * w.y; gl[2] += xv * w.z; gl[3] += xv * w.w; } }
#pragma unroll
        for (int g = 0; g < 4; ++g) gl[g] = wave_sum(gl[g]) + bg[g];
        int gsel = 0; float gmax = gl[0];
#pragma unroll
        for (int g = 1; g < 4; ++g) if (gl[g] > gmax) { gmax = gl[g]; gsel = g; }
        float gden = 0.f;
#pragma unroll
        for (int g = 0; g < 4; ++g) gden += __expf(gl[g] - gmax);
        const float gwt = 1.f / gden;
        gsel = __builtin_amdgcn_readfirstlane(gsel);
        float el[8] = {0.f, 0.f, 0.f, 0.f, 0.f, 0.f, 0.f, 0.f};
        const GAS f32x4* wr4 = (const GAS f32x4*)(wrt + (size_t)gsel * DM * 8);
#pragma unroll
        for (int j = 0; j < 8; ++j)
#pragma unroll
            for (int q = 0; q < 4; ++q) { const int d = 4 * (lane + 64 * j) + q; const f32x4 wa = wr4[2 * d], wb = wr4[2 * d + 1]; const float xv = v[j][q];
                el[0] += xv * wa.x; el[1] += xv * wa.y; el[2] += xv * wa.z; el[3] += xv * wa.w; el[4] += xv * wb.x; el[5] += xv * wb.y; el[6] += xv * wb.z; el[7] += xv * wb.w; }
#pragma unroll
        for (int e = 0; e < 8; ++e) el[e] = wave_sum(el[e]) + brt[gsel * 8 + e];
        int i1 = 0; float v1 = el[0];
#pragma unroll
        for (int e = 1; e < 8; ++e) if (el[e] > v1) { v1 = el[e]; i1 = e; }
        int i2 = -1; float v2 = -INFINITY;
#pragma unroll
        for (int e = 0; e < 8; ++e) if (e != i1 && el[e] > v2) { v2 = el[e]; i2 = e; }
        const float e2 = __expf(v2 - v1), w1 = gwt / (1.f + e2), w2 = gwt * e2 / (1.f + e2);
        if (lane < 2) { const int ex = gsel * 8 + (lane == 0 ? i1 : i2); const unsigned slot = __hip_atomic_fetch_add(F.ctl + CW_CNT + 64 * ex, 1u, RLX_AGENT);
            if (slot < (unsigned)MTOK) list[(size_t)ex * MTOK + slot] = (unsigned)m * 2u + (unsigned)lane;
            tokw[2 * m + lane] = lane == 0 ? w1 : w2; }
    }
    LAS float* scr = (LAS float*)(F.lds + RING_OFF + F.wave * 16384);
    bf16* WGU = (bf16*)(F.ws + WS_WGU); bf16* WD = (bf16*)(F.ws + WS_WD);
    constexpr int IGU = (DM / 64) * (DEXP / 32), IDN = (DEXP / 64) * (DM / 32), IPE = 2 * IGU + IDN;
    for (int it = gw; it < NEXP * IPE; it += NGW) {
        const int e = it / IPE; int r = it % IPE;
        if (r < 2 * IGU) { const int up = r >= IGU; if (up) r -= IGU; const int nblk = DEXP / 32, kb = r / nblk, nb = r % nblk, n0 = 32 * nb;
            const float* W = (up ? F.in[19] : F.in[18]) + (size_t)e * DM * DEXP;
            transpose_item(W, DEXP, WGU, DM, (size_t)e * 1024 + 256 * (n0 >> 7) + (n0 & 127) + (up ? 128 : 0), 64 * kb, 64 * kb, n0, scr, lane); }
        else { r -= 2 * IGU; const int nblk = DM / 32, kb = r / nblk, nb = r % nblk;
            transpose_item(F.in[20] + (size_t)e * DEXP * DM, DM, WD, DEXP, (size_t)e * DM + 32 * nb, 64 * kb, 64 * kb, 32 * nb, scr, lane); }
    }
}

__device__ __forceinline__ void p8_final(Frame& F) {
    const int gw = F.vcu * NWAVES + F.wave, NGW = F.G * NWAVES, lane = F.lane;
    float* X1 = F.out; const bf16* Y = (const bf16*)(F.ws + WS_Y); const float* tokw = (const float*)(F.ws + WS_TOKW); const float* g2 = F.in[21]; const float* b2 = F.in[22];
    for (int m = gw; m < MTOK; m += NGW) {
        GAS f32x4* xr = (GAS f32x4*)(X1 + (size_t)m * DM) + lane; const GAS v2u* y0 = (const GAS v2u*)(Y + (size_t)m * DM) + lane; const GAS v2u* y1 = (const GAS v2u*)(Y + ((size_t)MTOK + m) * DM) + lane;
        const float w0 = tokw[2 * m], w1 = tokw[2 * m + 1];
        f32x4 v[8]; float s = 0.f;
#pragma unroll
        for (int j = 0; j < 8; ++j) { const f32x4 x = xr[64 * j]; const v2u a = y0[64 * j], b = y1[64 * j];
            f32x4 ya; ya.x = bflo(a.x); ya.y = bfhi(a.x); ya.z = bflo(a.y); ya.w = bfhi(a.y); f32x4 yb; yb.x = bflo(b.x); yb.y = bfhi(b.x); yb.z = bflo(b.y); yb.w = bfhi(b.y);
            v[j] = x * ALPHA + ya * w0 + yb * w1; s += (v[j].x + v[j].y) + (v[j].z + v[j].w); }
        const float mean = wave_sum(s) * (1.f / DM); float s2 = 0.f;
#pragma unroll
        for (int j = 0; j < 8; ++j) { v[j] = v[j] - mean; s2 += (v[j].x * v[j].x + v[j].y * v[j].y) + (v[j].z * v[j].z + v[j].w * v[j].w); }
        const float rstd = 1.f / sqrtf(wave_sum(s2) * (1.f / DM) + LN_EPS);
#pragma unroll
        for (int j = 0; j < 8; ++j) { const f32x4 gg = ((const GAS f32x4*)g2)[lane + 64 * j], bb = ((const GAS f32x4*)b2)[lane + 64 * j]; xr[64 * j] = v[j] * rstd * gg + bb; }
    }
}

struct Args { const float* in[23]; float* out; unsigned char* ws; int ph_lo, ph_hi, li, pad; };
__global__ void __launch_bounds__(NWAVES * 64, 2) fwd(Args args) {
    extern __shared__ __attribute__((aligned(16))) unsigned char lds[];
    Frame F;
    F.lds = (LAS unsigned char*)lds;
    F.MISC = (volatile LAS unsigned*)(F.lds + MISC_OFF);
    F.tid = threadIdx.x; F.lane = F.tid & 63; F.wave = __builtin_amdgcn_readfirstlane(F.tid >> 6);
    F.G = gridDim.x; { const int bx = blockIdx.x; F.vcu = (F.G % 8 == 0) ? (bx % 8) * (F.G / 8) + bx / 8 : bx; }
    F.ws = args.ws; F.ctl = (gu32*)(args.ws + WS_CTL); F.out = args.out;
#pragma unroll
    for (int i = 0; i < 23; ++i) F.in[i] = args.in[i];
    for (int u = F.tid; u < (LDS_BYTES - LDSCTL_OFF) / 4; u += NWAVES * 64) ((LAS unsigned*)(F.lds + LDSCTL_OFF))[u] = 0u;
    __syncthreads();
    XcdBarrier bar; bar.bar = (unsigned*)(F.ctl + CW_BAR); bar.x = 0; bar.st = nullptr;
    if (N_LAUNCHES == 1) bar = xcd_barrier_post((unsigned*)(F.ctl + CW_BAR), F.MISC + 8);
#define GRID_BAR() do { if (N_LAUNCHES == 1) xcd_barrier(bar); } while (0)
    const int lo = args.ph_lo, hi = args.ph_hi;
#define IN(k) (lo <= (k) && (k) < hi)
#define BOTH(k) (IN(k) && IN((k) + 1))
    unsigned char* ws = args.ws;
    const int bx = (int)blockIdx.x;

    if (IN(0)) { p0_prologue(F); if (BOTH(0)) GRID_BAR(); }

    if (IN(1)) {
        { pg8::Gemm g{(const bf16*)(ws + WS_XB), (const bf16*)(ws + WS_WIN), DM, DM, DM}; pg8::StaticOrder S; S.init(MTOK, IN_DIM, F.G, bx);
          EpiProj E{(bf16*)(ws + WS_PA), (bf16*)(ws + WS_GATES), F.in[5]};
          pg8::gemm_phase<EpiProj, pg8::StaticOrder, true, false>(F.lds + RING_OFF, g, S, E); }
        { pg8::Gemm g{(const bf16*)(ws + WS_MEMN), (const bf16*)(ws + WS_WKV), DM, DM, DM}; pg8::StaticOrder S; S.init(BATCH * MEM_LEN, 2 * MEM_DIM, F.G, (bx + F.G / 2) % F.G);
          EpiPlain E{(bf16*)(ws + WS_MKV), 2 * MEM_DIM};
          pg8::gemm_phase<EpiPlain, pg8::StaticOrder, true, false>(F.lds + RING_OFF, g, S, E); }
        if (BOTH(1)) GRID_BAR();
    }

    if (IN(2)) { p2_attention(F); if (BOTH(2)) GRID_BAR(); }

    if (IN(3)) { p3_conv_combine(F); if (BOTH(3)) GRID_BAR(); }

    if (IN(4)) {
        const bf16* AC = (const bf16*)(ws + WS_ACAT); const bf16* WC = (const bf16*)(ws + WS_WCAT); const bf16* GT = (const bf16*)(ws + WS_GATES);
        float* macc = (float*)(ws + WS_MACC); bf16* merged = (bf16*)(ws + WS_MERGED);
        pg8::StaticOrder S; S.init(MTOK, DM, F.G, bx);
        { pg8::Gemm g{AC, WC, CONV_DIM, KCAT, KCAT}; EpiMerge<0> E{GT, macc, merged}; pg8::gemm_phase<EpiMerge<0>, pg8::StaticOrder, true, false>(F.lds + RING_OFF, g, S, E); }
        { pg8::Gemm g{AC + 1024, WC + 1024, DIL_OUT, KCAT, KCAT}; EpiMerge<1> E{GT, macc, merged}; pg8::gemm_phase<EpiMerge<1>, pg8::StaticOrder, true, false>(F.lds + RING_OFF, g, S, E); }
        { pg8::Gemm g{AC + 1536, WC + 1536, MEM_DIM, KCAT, KCAT}; EpiMerge<2> E{GT, macc, merged}; pg8::gemm_phase<EpiMerge<2>, pg8::StaticOrder, true, false>(F.lds + RING_OFF, g, S, E); }
        if (BOTH(4)) GRID_BAR();
    }

    if (IN(5)) {
        pg8::Gemm g{(const bf16*)(ws + WS_MERGED), (const bf16*)(ws + WS_WO), DM, DM, DM}; pg8::StaticOrder S; S.init(MTOK, DM, F.G, bx);
        EpiWo E{F.in[0], F.out};
        pg8::gemm_phase<EpiWo, pg8::StaticOrder, true, false>(F.lds + RING_OFF, g, S, E);
        if (BOTH(5)) GRID_BAR();
    }

    if (IN(6)) { p5_ln_route(F); if (BOTH(6)) GRID_BAR(); }

    if (IN(7)) {
        moe_plan(F);
        pg8::Gemm g{(const bf16*)(ws + WS_X1B), (const bf16*)(ws + WS_WGU), DM, DM, DM};
        MoeOrder S{(const LAS int*)(F.lds + TAB_OFF), (const unsigned*)(ws + WS_LIST), 4, F.G, bx};
        EpiGateUp E{(bf16*)(ws + WS_H)};
        pg8::gemm_phase<EpiGateUp, MoeOrder, true, true>(F.lds + RING_OFF, g, S, E);
        if (BOTH(7)) GRID_BAR();
    }

    if (IN(8)) {
        moe_plan(F);
        pg8::Gemm g{(const bf16*)(ws + WS_H), (const bf16*)(ws + WS_WD), DEXP, DEXP, DEXP};
        MoeOrder S{(const LAS int*)(F.lds + TAB_OFF), (const unsigned*)(ws + WS_LIST), 8, F.G, bx};
        EpiDown E{(bf16*)(ws + WS_Y), (const unsigned*)(ws + WS_LIST)};
        pg8::gemm_phase<EpiDown, MoeOrder, true, false>(F.lds + RING_OFF, g, S, E);
        if (BOTH(8)) GRID_BAR();
    }

    if (IN(9)) { p8_final(F); }
#undef IN
#undef BOTH
#undef GRID_BAR
}

extern "C" void kernel_launch(void* const* d_in, const int* in_sizes, int n_in, void* d_out, int out_size, void* d_ws, size_t ws_size, hipStream_t stream) {
    static int grid = 0;
    if (grid == 0) {
        if (n_in != 23 || in_sizes[0] != MTOK * DM || out_size != MTOK * DM || ws_size < WS_END) { fprintf(stderr, "kernel_launch: unexpected shapes/workspace (n_in %d, ws %zu); nothing launched\n", n_in, ws_size); grid = -1; return; }
        int dev = 0, cus = 0, per_cu = 0;
        if (hipGetDevice(&dev) != hipSuccess || hipDeviceGetAttribute(&cus, hipDeviceAttributeMultiprocessorCount, dev) != hipSuccess) { grid = -1; return; }
        if (hipFuncSetAttribute((const void*)fwd, hipFuncAttributeMaxDynamicSharedMemorySize, LDS_BYTES) != hipSuccess) { fprintf(stderr, "kernel_launch: hipFuncSetAttribute failed\n"); grid = -1; return; }
        if (hipOccupancyMaxActiveBlocksPerMultiprocessor(&per_cu, (const void*)fwd, NWAVES * 64, LDS_BYTES) != hipSuccess || per_cu < 1) fprintf(stderr, "kernel_launch: occupancy query reports %d\n", per_cu);
        (void)hipGetLastError();
        grid = cus;
    }
    if (grid < 0) return;
    if (hipMemsetAsync((char*)d_ws + WS_CTL, 0, CTL_ZERO_BYTES, stream) != hipSuccess) return;
    Args a{};
    for (int i = 0; i < 23; ++i) a.in[i] = (const float*)d_in[i];
    a.out = (float*)d_out; a.ws = (unsigned char*)d_ws;
    for (int li = 0; li < N_LAUNCHES; ++li) {
        a.ph_lo = (N_LAUNCHES == 1) ? 0 : li; a.ph_hi = (N_LAUNCHES == 1) ? N_PHASES : li + 1; a.li = li;
        hipLaunchKernelGGL(fwd, dim3(grid), dim3(NWAVES * 64), LDS_BYTES, stream, a);
        if (hipPeekAtLastError() != hipSuccess) { fprintf(stderr, "kernel_launch: launch %d failed\n", li); break; }
    }
}
```

```cpp
#include <hip/hip_runtime.h>
#include <cstdio>
#include <cstdint>

#ifndef MK_N_LAUNCHES
#define MK_N_LAUNCHES 1
#endif

namespace pg8 {
#define PG8_LAS __attribute__((address_space(3)))
typedef unsigned short bf16_t;
typedef short bf16x8 __attribute__((ext_vector_type(8)));
typedef float f32x4 __attribute__((ext_vector_type(4)));
typedef unsigned u32x4 __attribute__((ext_vector_type(4)));
typedef unsigned u32x2 __attribute__((ext_vector_type(2)));
constexpr int BM = 256, BK = 64, HALF = 128, HTB = HALF * BK * 2, STAGE_BYTES = 8 * HTB, NXCD = 8, WGM = 8;

__host__ __device__ __forceinline__ int lds_byte(int r, int c) { const int st = (r >> 4) * 2 + (c >> 5), rr = r & 15, cc = c & 31, ob = rr * 64 + cc * 2; return st * 1024 + (ob ^ (((ob >> 9) & 1) << 5)); }
__host__ __device__ __forceinline__ void stage_rc(int b, int& R, int& C) { const int st = b / 1024, sb = b % 1024, swz = sb ^ (((sb >> 9) & 1) << 5); R = (st >> 1) * 16 + swz / 64; C = (st & 1) * 32 + (swz % 64) / 2; }
__host__ __device__ __forceinline__ int perm32(int rho) { const int n = rho >> 4, i = rho & 15; return 8 * (i >> 2) + 4 * n + (i & 3); }

struct Unit { int pm, pn, pb, aux, nv; };
struct Gemm { const bf16_t* A; const bf16_t* Bt; int K, lda, ldb; };

struct StaticOrder {
    int nM, nN, nwg, G, c;
    __host__ __device__ void init(int M, int N, int G_, int c_) { nM = M / BM; nN = N / BM; nwg = nM * nN; G = G_; c = c_; }
    __host__ __device__ bool next(int i, Unit& u) const {
        const long L = (long)i * G + c; if (L >= nwg) return false;
        int wgid = (int)L; { const int q = nwg / NXCD, r = nwg % NXCD, xcd = wgid % NXCD, off = wgid / NXCD; wgid = (xcd < r ? xcd * (q + 1) : r * (q + 1) + (xcd - r) * q) + off; }
        const int nig = WGM * nN, gid = wgid / nig, fm = gid * WGM, gsz = (nM - fm) < WGM ? (nM - fm) : WGM;
        u.pm = fm + ((wgid % nig) % gsz); u.pn = (wgid % nig) / gsz; u.pb = u.pn; u.aux = 0; u.nv = 256; return true;
    }
    __device__ __forceinline__ unsigned row_of(const Unit&, int r) const { return (unsigned)r; }
    __device__ __forceinline__ void a_ready(const Unit&) const {}
    __device__ __forceinline__ void done(const Unit&) const {}
};

__device__ __forceinline__ unsigned cvt_pk_bf16(float lo, float hi) { unsigned r; asm volatile("v_cvt_pk_bf16_f32 %0, %1, %2" : "=v"(r) : "v"(lo), "v"(hi)); return r; }

template <class Epi, class Sched, bool ALIGN_EPI, bool GATHER, bool MIDHOOK = false>
__device__ __forceinline__ void gemm_phase(PG8_LAS unsigned char* lds, const Gemm g, const Sched& S, const Epi& E) {
    const int tid = threadIdx.x, wid = __builtin_amdgcn_readfirstlane(tid >> 6), lane = tid & 63, wr = wid >> 2, wc = wid & 3, fr = lane & 15, fq = lane >> 4;
    const int K = g.K, nt = K / BK;
    unsigned voffB[2], cvA0[2], cvA1[2], nvA0[2], nvA1[2]; int RA[2], CA[2];
#pragma unroll
    for (int i = 0; i < 2; ++i) { int R, C; stage_rc(tid * 16 + i * 8192, R, C); const int Rb = Epi::PERM ? ((R & ~31) + perm32(R & 31)) : R;
        RA[i] = R; CA[i] = C; voffB[i] = (unsigned)(Rb * g.ldb + C) * 2u; }
    const size_t kstep = (size_t)(BK * 2);
    const size_t hstepB = (size_t)HALF * g.ldb * 2, tstepB = 2 * hstepB, tstepA = (size_t)BM * g.lda * 2;
    const unsigned ldsw = (unsigned)wid * 1024u;
    const int aoff = lds_byte(wr * 64 + fr, fq * 8), boff = lds_byte(wc * 32 + fr, fq * 8);
#define PG8_SA(b, h) (((b) * 2 + (h)) * HTB)
#define PG8_SB(b, h) ((4 + (b) * 2 + (h)) * HTB)
#define PG8_STAGE(bufoff, gbase, voff) do { _Pragma("unroll") for (int _i = 0; _i < 2; ++_i) \
        __builtin_amdgcn_global_load_lds((const unsigned*)((const char*)(gbase) + (voff)[_i]), (PG8_LAS unsigned*)(lds + (bufoff) + ldsw + _i * 8192), 16, 0, 0); } while (0)
#define PG8_LDA(dst, b, h) do { _Pragma("unroll") for (int m = 0; m < 4; ++m) _Pragma("unroll") for (int k = 0; k < 2; ++k) dst[m][k] = *(const PG8_LAS bf16x8*)(lds + PG8_SA(b, h) + aoff + m * 2048 + k * 1024); } while (0)
#define PG8_LDB(dst, b, h) do { _Pragma("unroll") for (int n = 0; n < 2; ++n) _Pragma("unroll") for (int k = 0; k < 2; ++k) dst[n][k] = *(const PG8_LAS bf16x8*)(lds + PG8_SB(b, h) + boff + n * 2048 + k * 1024); } while (0)
#define PG8_MMA(ai, bj, At, Bt) do { __builtin_amdgcn_s_setprio(1); _Pragma("unroll") for (int m = 0; m < 4; ++m) _Pragma("unroll") for (int n = 0; n < 2; ++n) _Pragma("unroll") for (int k = 0; k < 2; ++k) \
        acc[ai][bj][m][n] = __builtin_amdgcn_mfma_f32_16x16x32_bf16(Bt[n][k], At[m][k], acc[ai][bj][m][n], 0, 0, 0); __builtin_amdgcn_s_setprio(0); } while (0)
#define PG8_WAIT_V(n) asm volatile("s_waitcnt vmcnt(" #n ")" ::: "memory")
#define PG8_WAIT_L(n) asm volatile("s_waitcnt lgkmcnt(" #n ")" ::: "memory")
#define PG8_BAR __builtin_amdgcn_s_barrier()
#define PG8_SCHED __builtin_amdgcn_sched_barrier(0)
#define PG8_ROWS(U, d0, d1) do { if constexpr (GATHER) { const unsigned _r0 = S.row_of(U, RA[0]), _r1 = S.row_of(U, RA[1]), _r2 = S.row_of(U, RA[0] + HALF), _r3 = S.row_of(U, RA[1] + HALF); \
        d0[0] = (_r0 * (unsigned)g.lda + (unsigned)CA[0]) * 2u; d0[1] = (_r1 * (unsigned)g.lda + (unsigned)CA[1]) * 2u; d1[0] = (_r2 * (unsigned)g.lda + (unsigned)CA[0]) * 2u; d1[1] = (_r3 * (unsigned)g.lda + (unsigned)CA[1]) * 2u; } \
      else { _Pragma("unroll") for (int _i = 0; _i < 2; ++_i) { d0[_i] = (unsigned)(RA[_i] * g.lda + CA[_i]) * 2u; d1[_i] = d0[_i] + (unsigned)(HALF * g.lda * 2); } } } while (0)
    Unit cur, nxt; int ui = 0;
    if (!S.next(0, cur)) return;
    f32x4 acc[2][2][4][2];
#pragma unroll
    for (int a = 0; a < 2; ++a)
#pragma unroll
        for (int b = 0; b < 2; ++b)
#pragma unroll
            for (int m = 0; m < 4; ++m)
#pragma unroll
                for (int n = 0; n < 2; ++n) acc[a][b][m][n] = (f32x4){0.f, 0.f, 0.f, 0.f};
    bf16x8 At[4][2], B0[2][2], B1[2][2];
    const char* cA = GATHER ? (const char*)g.A : (const char*)g.A + (size_t)cur.pm * tstepA; const char* cB = (const char*)g.Bt + (size_t)cur.pb * tstepB;
    S.a_ready(cur);
    PG8_ROWS(cur, cvA0, cvA1);
    PG8_STAGE(PG8_SB(0, 0), cB, voffB); PG8_STAGE(PG8_SB(0, 1), cB + hstepB, voffB); PG8_STAGE(PG8_SA(0, 0), cA, cvA0); PG8_STAGE(PG8_SA(0, 1), cA, cvA1);
    if (wr == 1) PG8_BAR;
    PG8_WAIT_V(2); PG8_BAR;
    PG8_STAGE(PG8_SB(1, 0), cB + kstep, voffB); PG8_STAGE(PG8_SA(1, 0), cA + kstep, cvA0); PG8_STAGE(PG8_SB(1, 1), cB + hstepB + kstep, voffB);
    PG8_WAIT_V(6); PG8_BAR;
    for (;;) {
        const bool has_next = S.next(ui + 1, nxt);
        const char* nA = has_next ? (GATHER ? (const char*)g.A : (const char*)g.A + (size_t)nxt.pm * tstepA) : cA; const char* nB = has_next ? (const char*)g.Bt + (size_t)nxt.pb * tstepB : cB;
#pragma unroll
        for (int i = 0; i < 2; ++i) { nvA0[i] = cvA0[i]; nvA1[i] = cvA1[i]; }
        for (int t = 0; t < nt; t += 2) {
            const bool last = (t == nt - 2);
            const char* a1 = cA + (size_t)(t + 1) * kstep;
            const char* a2 = last ? nA : cA + (size_t)(t + 2) * kstep; const char* b2 = last ? nB : cB + (size_t)(t + 2) * kstep;
            const char* a3 = a2 + kstep; const char* b3 = b2 + kstep;
            if (last && has_next) { S.a_ready(nxt); if constexpr (GATHER) { PG8_ROWS(nxt, nvA0, nvA1); } }
            if constexpr (MIDHOOK) { if (t == Epi::T1 || t == Epi::T2) E.mid(acc, cur, t == Epi::T1 ? 0 : 1, wr, wc, fr, fq); }
            unsigned xA0[2], xA1[2];
#pragma unroll
            for (int i = 0; i < 2; ++i) { xA0[i] = last ? nvA0[i] : cvA0[i]; xA1[i] = last ? nvA1[i] : cvA1[i]; }
            PG8_LDB(B0, 0, 0); PG8_LDB(B1, 0, 1); PG8_SCHED; PG8_LDA(At, 0, 0); PG8_STAGE(PG8_SA(1, 1), a1, cvA1);
            PG8_WAIT_V(8); PG8_WAIT_L(0); PG8_BAR; PG8_MMA(0, 0, At, B0); PG8_MMA(0, 1, At, B1); PG8_BAR; PG8_SCHED;
            PG8_LDA(At, 0, 1); PG8_STAGE(PG8_SB(0, 0), b2, voffB); PG8_STAGE(PG8_SB(0, 1), b2 + hstepB, voffB); PG8_STAGE(PG8_SA(0, 0), a2, xA0);
            PG8_WAIT_V(8); PG8_WAIT_L(0); PG8_BAR; PG8_MMA(1, 0, At, B0); PG8_MMA(1, 1, At, B1); PG8_BAR; PG8_SCHED;
            PG8_LDB(B0, 1, 0); PG8_LDB(B1, 1, 1); PG8_SCHED; PG8_LDA(At, 1, 0); PG8_STAGE(PG8_SA(0, 1), a2, xA1);
            PG8_WAIT_V(8); PG8_WAIT_L(0); PG8_BAR; PG8_MMA(0, 0, At, B0); PG8_MMA(0, 1, At, B1); PG8_BAR; PG8_SCHED;
            PG8_LDA(At, 1, 1); PG8_STAGE(PG8_SB(1, 0), b3, voffB); PG8_STAGE(PG8_SB(1, 1), b3 + hstepB, voffB); PG8_STAGE(PG8_SA(1, 0), a3, xA0);
            PG8_WAIT_V(8); PG8_WAIT_L(0); PG8_BAR; PG8_MMA(1, 0, At, B0); PG8_MMA(1, 1, At, B1); PG8_BAR; PG8_SCHED;
        }
        if constexpr (ALIGN_EPI) { if (wr == 0) PG8_BAR; }
        E(acc, cur, wr, wc, fr, fq); S.done(cur);
        if (!has_next) break;
#pragma unroll
        for (int a = 0; a < 2; ++a)
#pragma unroll
            for (int b = 0; b < 2; ++b)
#pragma unroll
                for (int m = 0; m < 4; ++m)
#pragma unroll
                    for (int n = 0; n < 2; ++n) acc[a][b][m][n] = (f32x4){0.f, 0.f, 0.f, 0.f};
        cur = nxt; cA = nA; cB = nB; ++ui;
#pragma unroll
        for (int i = 0; i < 2; ++i) { cvA0[i] = nvA0[i]; cvA1[i] = nvA1[i]; }
        if constexpr (ALIGN_EPI) { if (wr == 1) PG8_BAR; }
    }
    PG8_WAIT_V(0);
    if constexpr (!ALIGN_EPI) { if (wr == 0) PG8_BAR; }
    PG8_BAR;
#undef PG8_SA
#undef PG8_SB
#undef PG8_STAGE
#undef PG8_LDA
#undef PG8_LDB
#undef PG8_MMA
#undef PG8_WAIT_V
#undef PG8_WAIT_L
#undef PG8_BAR
#undef PG8_SCHED
#undef PG8_ROWS
}
}

#ifndef REP0
#define REP0 1
#endif
#ifndef REP1
#define REP1 1
#endif
#ifndef REP2
#define REP2 1
#endif
#ifndef REP4
#define REP4 1
#endif
#ifndef REP5
#define REP5 1
#endif
#ifndef REP7
#define REP7 1
#endif
#ifndef REP8
#define REP8 1
#endif
constexpr int NWAVES = 8;
constexpr int N_LAUNCHES = MK_N_LAUNCHES;
constexpr int N_PHASES = 10;
constexpr int BATCH = 8, SEQ = 2048, DM = 2048, MTOK = BATCH * SEQ;
constexpr int CONV_DIM = 1024, DIL_DIM = 1536, DIL_OUT = 512, MEM_LEN = 256, MEM_DIM = 1024, IN_DIM = 14848;
constexpr int NA = 8704, NGATE = 6144, KCAT = 2560;
constexpr int PA_CB = 0, PA_CC = 1024, PA_CH = 2048, PA_Q = 3072, PA_K = 4608, PA_V = 6144, PA_MQ = 7680;
constexpr int NEXP = 32, DEXP = 512, HROWS = 40960;
constexpr float LN_EPS = 1e-5f;
constexpr float ALPHA = 1.189207115002721f;

constexpr size_t MiB = 1u << 20;
constexpr size_t WS_CTL = 0, CTL_ZERO_BYTES = 1 * MiB;
constexpr size_t WS_LIST = 1 * MiB, WS_TOKW = 3 * MiB;
constexpr size_t WS_WCAT = 8 * MiB, WS_WKV = 18 * MiB, WS_WO = 26 * MiB, WS_MEMN = 34 * MiB, WS_MKV = 42 * MiB;
constexpr size_t WS_WIN = 50 * MiB, WS_XB = 108 * MiB, WS_PA = 172 * MiB, WS_GATES = 444 * MiB, WS_END = 636 * MiB;
constexpr size_t WS_ACAT = 50 * MiB;
constexpr size_t WS_DILO = 130 * MiB;
constexpr size_t WS_LSE = 162 * MiB;
constexpr size_t WS_MACC = 172 * MiB;
constexpr size_t WS_MERGED = 300 * MiB;
constexpr size_t WS_X1B = 364 * MiB;
constexpr size_t WS_WGU = 444 * MiB;
constexpr size_t WS_WD = 572 * MiB;
constexpr size_t WS_H = 50 * MiB;
constexpr size_t WS_Y = 172 * MiB;
static_assert(WS_WIN + (size_t)IN_DIM * DM * 2 <= WS_XB && WS_XB + (size_t)MTOK * DM * 2 <= WS_PA && WS_PA + (size_t)MTOK * NA * 2 <= WS_GATES && WS_GATES + (size_t)MTOK * NGATE * 2 <= WS_END, "ws map");
static_assert(WS_ACAT + (size_t)MTOK * KCAT * 2 <= WS_PA && WS_MACC + (size_t)MTOK * DM * 4 <= WS_MERGED && WS_MERGED + (size_t)MTOK * DM * 2 <= WS_X1B && WS_X1B + (size_t)MTOK * DM * 2 <= WS_WGU, "ws map 2");
static_assert(WS_WGU + (size_t)NEXP * 1024 * DM * 2 <= WS_WD && WS_WD + (size_t)NEXP * DM * DEXP * 2 <= WS_END && WS_H + (size_t)HROWS * DEXP * 2 <= WS_PA && WS_Y + (size_t)2 * MTOK * DM * 2 <= WS_X1B, "ws map 3");

constexpr int CW_TMO = 0, CW_CODE = 1, CW_BAR = 4096, CW_CNT = 16384;

constexpr int RING_OFF = 0, RING_BYTES = 131072;
constexpr int LDSCTL_OFF = RING_BYTES, MISC_OFF = LDSCTL_OFF + 320, TAB_OFF = LDSCTL_OFF + 1024;
constexpr int LDS_BYTES = 147456;
static_assert(TAB_OFF + 2048 <= LDS_BYTES, "LDS map");

#define GAS __attribute__((address_space(1)))
#define LAS __attribute__((address_space(3)))
typedef unsigned short bf16;
typedef unsigned v4u __attribute__((ext_vector_type(4)));
typedef unsigned v2u __attribute__((ext_vector_type(2)));
typedef float f32x4 __attribute__((ext_vector_type(4)));
typedef GAS unsigned gu32;
#define RLX_AGENT __ATOMIC_RELAXED, __HIP_MEMORY_SCOPE_AGENT
#define LDS_WAIT() asm volatile("s_waitcnt lgkmcnt(0)" ::: "memory")
#define VM_WAIT() asm volatile("s_waitcnt vmcnt(0)" ::: "memory")
__device__ __forceinline__ unsigned f2bf(float f) { unsigned u = __builtin_bit_cast(unsigned, f); return (u + 0x7fffu + ((u >> 16) & 1u)) >> 16; }
__device__ __forceinline__ unsigned pk2(float lo, float hi) { return f2bf(lo) | (f2bf(hi) << 16); }
__device__ __forceinline__ float bflo(unsigned w) { return __builtin_bit_cast(float, w << 16); }
__device__ __forceinline__ float bfhi(unsigned w) { return __builtin_bit_cast(float, w & 0xffff0000u); }
__device__ __forceinline__ float bf1(bf16 b) { return __builtin_bit_cast(float, (unsigned)b << 16); }

#define XB_TMO      128
#define XB_XCNT(j)  (256  + 64 * (j))
#define XB_XSUB(j)  (1280 + 64 * (j))
#define XB_XGEN(j)  (2304 + 64 * (j))
#define XB_TOP      3328
#define XB_TOPGEN   3392
#define XCD_BAR_WORDS 3456
#define XB_SPIN_CAP (1u << 18)
__device__ __forceinline__ unsigned xb_ld(unsigned* p)              { return __hip_atomic_load(p, __ATOMIC_RELAXED, __HIP_MEMORY_SCOPE_AGENT); }
__device__ __forceinline__ unsigned xb_add(unsigned* p, unsigned v) { return __hip_atomic_fetch_add(p, v, __ATOMIC_RELAXED, __HIP_MEMORY_SCOPE_AGENT); }
__device__ __forceinline__ unsigned xb_xcc_id() { return (unsigned)__builtin_amdgcn_s_getreg((3 << 11) | 20) & 0xFu; }
#define XB_SPIN(cond, bar) do { unsigned _sp = 0; while (cond) { __builtin_amdgcn_s_sleep(1); \
    if ((++_sp & 255u) == 0u) { if (xb_ld(&(bar)[XB_TMO])) break; if (_sp > XB_SPIN_CAP) { atomicAdd(&(bar)[XB_TMO], 1u); break; } } } } while (0)
struct XcdBarrier { unsigned* bar; unsigned x; volatile LAS unsigned* st; };
__device__ __forceinline__ XcdBarrier xcd_barrier_post(unsigned* bar, volatile LAS unsigned* st) {
    XcdBarrier b; b.bar = bar; b.x = xb_xcc_id(); b.st = st;
    if (threadIdx.x == 0) (void)xb_add(&bar[XB_XCNT(b.x)], 1u);
    return b;
}
__device__ __forceinline__ void xcd_barrier_complete(unsigned* bar, unsigned x, unsigned& nloc, unsigned& nx) {
    const unsigned G = gridDim.x * gridDim.y * gridDim.z;
    unsigned sum, cnt, mine, sp = 0u;
    for (;;) {
        sum = 0u; cnt = 0u; mine = 0u;
#pragma unroll
        for (unsigned j = 0; j < 16; ++j) { const unsigned c = xb_ld(&bar[XB_XCNT(j)]); sum += c; cnt += (c > 0u) ? 1u : 0u; mine = (j == x) ? c : mine; }
        if (sum == G) break;
        __builtin_amdgcn_s_sleep(1);
        if ((++sp & 255u) == 0u) { if (xb_ld(&bar[XB_TMO])) break; if (sp > XB_SPIN_CAP) { atomicAdd(&bar[XB_TMO], 1u); break; } }
    }
    nloc = mine > 0u ? mine : 1u; nx = cnt > 0u ? cnt : 1u;
}
__device__ __forceinline__ void xcd_barrier(const XcdBarrier& b) {
    asm volatile("s_waitcnt vmcnt(0)" ::: "memory");
    __syncthreads();
    if (threadIdx.x == 0) {
        unsigned* bar = b.bar;
        __builtin_amdgcn_s_waitcnt(0);
        unsigned nloc = b.st[0], nx = b.st[1];
        if (nloc == 0u) { xcd_barrier_complete(bar, b.x, nloc, nx); b.st[0] = nloc; b.st[1] = nx; }
        const unsigned old = xb_add(&bar[XB_XSUB(b.x)], 1u);
        const unsigned gen = old / nloc;
        if (old + 1u == (gen + 1u) * nloc) {
            __builtin_amdgcn_fence(__ATOMIC_RELEASE, "agent");
            asm volatile("s_waitcnt vmcnt(0)" ::: "memory");
            const unsigned og = xb_add(&bar[XB_TOP], 1u);
            const unsigned tg = og / nx;
            if (og + 1u == (tg + 1u) * nx) xb_add(&bar[XB_TOPGEN], 1u);
            else XB_SPIN(xb_ld(&bar[XB_TOPGEN]) == tg, bar);
            __builtin_amdgcn_fence(__ATOMIC_ACQUIRE, "agent");
            xb_add(&bar[XB_XGEN(b.x)], 1u);
            asm volatile("s_waitcnt vmcnt(0)" ::: "memory");
        } else {
            XB_SPIN(xb_ld(&bar[XB_XGEN(b.x)]) == gen, bar);
            __builtin_amdgcn_fence(__ATOMIC_ACQUIRE, "agent");
            asm volatile("s_waitcnt vmcnt(0)" ::: "memory");
        }
    }
    __syncthreads();
}

struct Frame {
    LAS unsigned char* lds;
    volatile LAS unsigned* MISC;
    gu32* ctl;
    int tid, lane, wave;
    int vcu, G;
    unsigned char* ws;
    const float* in[23];
    float* out;
};

__device__ __forceinline__ float wave_sum(float v) {
#pragma unroll
    for (int o = 1; o < 64; o <<= 1) v += __shfl_xor(v, o);
    return v;
}
__device__ __forceinline__ float wave_max(float v) {
#pragma unroll
    for (int o = 1; o < 64; o <<= 1) v = fmaxf(v, __shfl_xor(v, o));
    return v;
}

__device__ __forceinline__ void transpose_item(const float* W, int N, bf16* WT, int ldt, size_t drow0, int dcol0, int k0, int n0, LAS float* scr, int lane) {
#pragma unroll
    for (int i = 0; i < 32; ++i) { const int kk = 2 * i + (lane >> 5); scr[kk * 33 + (lane & 31)] = W[(size_t)(k0 + kk) * N + n0 + (lane & 31)]; }
    LDS_WAIT(); asm volatile("" ::: "memory");
    const int c = lane & 7;
#pragma unroll
    for (int j = 0; j < 4; ++j) { const int n = (lane >> 3) + 8 * j; const LAS float* s = scr + (8 * c) * 33 + n;
        v4u o; o.x = pk2(s[0 * 33], s[1 * 33]); o.y = pk2(s[2 * 33], s[3 * 33]); o.z = pk2(s[4 * 33], s[5 * 33]); o.w = pk2(s[6 * 33], s[7 * 33]);
        *(GAS v4u*)(WT + (drow0 + n) * ldt + dcol0 + 8 * c) = o; }
    LDS_WAIT(); asm volatile("" ::: "memory");
}
__device__ __forceinline__ void transpose_matrix(Frame& F, LAS float* scr, const float* W, int K, int N, bf16* WT, int ldt, int dcol_base, int gw, int NGW) {
    const int nblk = N / 32, nitems = (K / 64) * nblk;
    for (int it = gw; it < nitems; it += NGW) { const int kb = it / nblk, nb = it % nblk; transpose_item(W, N, WT, ldt, (size_t)(32 * nb), dcol_base + 64 * kb, 64 * kb, 32 * nb, scr, F.lane); }
}

__device__ __forceinline__ void p0_prologue(Frame& F) {
    LAS float* scr = (LAS float*)(F.lds + RING_OFF + F.wave * 16384);
    const int gw = F.vcu * NWAVES + F.wave, NGW = F.G * NWAVES;
    unsigned char* ws = F.ws;
    transpose_matrix(F, scr, F.in[4], DM, IN_DIM, (bf16*)(ws + WS_WIN), DM, 0, gw, NGW);
    transpose_matrix(F, scr, F.in[7], CONV_DIM, DM, (bf16*)(ws + WS_WCAT), KCAT, 0, gw, NGW);
    transpose_matrix(F, scr, F.in[8], DIL_OUT, DM, (bf16*)(ws + WS_WCAT), KCAT, 1024, gw, NGW);
    transpose_matrix(F, scr, F.in[10], MEM_DIM, DM, (bf16*)(ws + WS_WCAT), KCAT, 1536, gw, NGW);
    transpose_matrix(F, scr, F.in[9], DM, 2 * MEM_DIM, (bf16*)(ws + WS_WKV), DM, 0, gw, NGW);
    transpose_matrix(F, scr, F.in[11], DM, DM, (bf16*)(ws + WS_WO), DM, 0, gw, NGW);
    { const GAS f32x4* x4 = (const GAS f32x4*)F.in[0]; GAS v4u* o4 = (GAS v4u*)(ws + WS_XB); const size_t n8 = (size_t)MTOK * DM / 8;
      for (size_t i = (size_t)gw * 64 + F.lane; i < n8; i += (size_t)NGW * 64) { const f32x4 a = x4[2 * i], b = x4[2 * i + 1]; v4u o; o.x = pk2(a.x, a.y); o.y = pk2(a.z, a.w); o.z = pk2(b.x, b.y); o.w = pk2(b.z, b.w); o4[i] = o; } }
    { const float* gm = F.in[2]; const float* bm = F.in[3]; bf16* mo = (bf16*)(ws + WS_MEMN);
      for (int m = gw; m < BATCH * MEM_LEN; m += NGW) {
        const GAS f32x4* xr = (const GAS f32x4*)(F.in[1] + (size_t)m * DM) + F.lane; f32x4 v[8]; float s = 0.f;
#pragma unroll
        for (int j = 0; j < 8; ++j) { v[j] = xr[64 * j]; s += (v[j].x + v[j].y) + (v[j].z + v[j].w); }
        const float mean = wave_sum(s) * (1.f / DM); float s2 = 0.f;
#pragma unroll
        for (int j = 0; j < 8; ++j) { v[j] = v[j] - mean; s2 += (v[j].x * v[j].x + v[j].y * v[j].y) + (v[j].z * v[j].z + v[j].w * v[j].w); }
        const float rstd = 1.f / sqrtf(wave_sum(s2) * (1.f / DM) + LN_EPS);
        GAS v2u* o8 = (GAS v2u*)(mo + (size_t)m * DM) + F.lane;
#pragma unroll
        for (int j = 0; j < 8; ++j) { const f32x4 gg = ((const GAS f32x4*)gm)[F.lane + 64 * j], bb = ((const GAS f32x4*)bm)[F.lane + 64 * j]; const f32x4 y = v[j] * rstd * gg + bb;
            v2u o; o.x = pk2(y.x, y.y); o.y = pk2(y.z, y.w); o8[64 * j] = o; }
      } }
}

using pg8::Unit; using pg8::cvt_pk_bf16; using pg8::HALF; using pg8::BM;
struct EpiProj {
    static constexpr bool PERM = true;
    bf16* PA; bf16* GT; const float* bias;
    __device__ __forceinline__ void operator()(const f32x4 (&acc)[2][2][4][2], const Unit& u, int wr, int wc, int fr, int fq) const {
        const int row0 = u.pm * BM + wr * 64 + fr; const bool isg = u.pn >= NA / 256;
        bf16* base = isg ? GT : PA; const int ldc = isg ? NGATE : NA; const int colt = isg ? (u.pn - NA / 256) * BM : u.pn * BM;
        const int col0 = colt + wc * 32 + 8 * fq, bcol0 = u.pn * BM + wc * 32 + 8 * fq;
        f32x4 bv[2][2];
#pragma unroll
        for (int bj = 0; bj < 2; ++bj)
#pragma unroll
            for (int n = 0; n < 2; ++n) bv[bj][n] = *(const f32x4*)(bias + bcol0 + bj * HALF + 4 * n);
#pragma unroll
        for (int ai = 0; ai < 2; ++ai)
#pragma unroll
            for (int m = 0; m < 4; ++m) { bf16* rowp = base + (size_t)(row0 + ai * HALF + m * 16) * ldc + col0;
#pragma unroll
                for (int bj = 0; bj < 2; ++bj) { f32x4 v0 = acc[ai][bj][m][0] + bv[bj][0], v1 = acc[ai][bj][m][1] + bv[bj][1];
                    if (isg) {
#pragma unroll
                        for (int j = 0; j < 4; ++j) { v0[j] = __builtin_amdgcn_rcpf(1.f + __builtin_amdgcn_exp2f(-1.4426950408889634f * v0[j])); v1[j] = __builtin_amdgcn_rcpf(1.f + __builtin_amdgcn_exp2f(-1.4426950408889634f * v1[j])); } }
                    pg8::u32x4 w; w.x = cvt_pk_bf16(v0[0], v0[1]); w.y = cvt_pk_bf16(v0[2], v0[3]); w.z = cvt_pk_bf16(v1[0], v1[1]); w.w = cvt_pk_bf16(v1[2], v1[3]);
                    *(pg8::u32x4*)(rowp + bj * HALF) = w; } }
    }
};
struct EpiPlain {
    static constexpr bool PERM = true;
    bf16* O; int ldc;
    __device__ __forceinline__ void operator()(const f32x4 (&acc)[2][2][4][2], const Unit& u, int wr, int wc, int fr, int fq) const {
        const int row0 = u.pm * BM + wr * 64 + fr, col0 = u.pn * BM + wc * 32 + 8 * fq;
#pragma unroll
        for (int ai = 0; ai < 2; ++ai)
#pragma unroll
            for (int m = 0; m < 4; ++m) { bf16* rowp = O + (size_t)(row0 + ai * HALF + m * 16) * ldc + col0;
#pragma unroll
                for (int bj = 0; bj < 2; ++bj) { const f32x4 v0 = acc[ai][bj][m][0], v1 = acc[ai][bj][m][1];
                    pg8::u32x4 w; w.x = cvt_pk_bf16(v0[0], v0[1]); w.y = cvt_pk_bf16(v0[2], v0[3]); w.z = cvt_pk_bf16(v1[0], v1[1]); w.w = cvt_pk_bf16(v1[2], v1[3]);
                    *(pg8::u32x4*)(rowp + bj * HALF) = w; } }
    }
};
struct EpiMerged {
    static constexpr bool PERM = true; static constexpr int T1 = CONV_DIM / 64, T2 = (CONV_DIM + DIL_OUT) / 64;
    const bf16* GT; bf16* merged;
    __device__ __forceinline__ void mid(f32x4 (&acc)[2][2][4][2], const Unit& u, int which, int wr, int wc, int fr, int fq) const {
        const int row0 = u.pm * BM + wr * 64 + fr, col0 = u.pn * BM + wc * 32 + 8 * fq;
        const bf16* ga = GT + (size_t)row0 * NGATE + which * DM + col0;
#pragma unroll
        for (int ai = 0; ai < 2; ++ai) {
            v4u a[4][2], b[4][2];
#pragma unroll
            for (int m = 0; m < 4; ++m)
#pragma unroll
                for (int bj = 0; bj < 2; ++bj) { const bf16* p = ga + (size_t)(ai * HALF + m * 16) * NGATE + bj * HALF; a[m][bj] = *(const v4u*)p; b[m][bj] = *(const v4u*)(p + DM); }
#pragma unroll
            for (int m = 0; m < 4; ++m)
#pragma unroll
                for (int bj = 0; bj < 2; ++bj) { const unsigned aw[4] = {a[m][bj].x, a[m][bj].y, a[m][bj].z, a[m][bj].w}, bw[4] = {b[m][bj].x, b[m][bj].y, b[m][bj].z, b[m][bj].w};
#pragma unroll
                    for (int q = 0; q < 4; ++q) { const float r0 = bflo(aw[q]) * __builtin_amdgcn_rcpf(fmaxf(bflo(bw[q]), 1e-30f)), r1 = bfhi(aw[q]) * __builtin_amdgcn_rcpf(fmaxf(bfhi(bw[q]), 1e-30f));
                        acc[ai][bj][m][q >> 1][2 * (q & 1)] *= r0; acc[ai][bj][m][q >> 1][2 * (q & 1) + 1] *= r1; } }
        }
    }
    __device__ __forceinline__ void operator()(const f32x4 (&acc)[2][2][4][2], const Unit& u, int wr, int wc, int fr, int fq) const {
        const int row0 = u.pm * BM + wr * 64 + fr, col0 = u.pn * BM + wc * 32 + 8 * fq;
#pragma unroll
        for (int ai = 0; ai < 2; ++ai)
#pragma unroll
            for (int m = 0; m < 4; ++m) { const size_t row = (size_t)(row0 + ai * HALF + m * 16);
#pragma unroll
                for (int bj = 0; bj < 2; ++bj) { const v4u g = *(const v4u*)(GT + row * NGATE + 2 * DM + col0 + bj * HALF); const f32x4 v0 = acc[ai][bj][m][0], v1 = acc[ai][bj][m][1];
                    pg8::u32x4 w; w.x = cvt_pk_bf16(v0[0] * bflo(g.x), v0[1] * bfhi(g.x)); w.y = cvt_pk_bf16(v0[2] * bflo(g.y), v0[3] * bfhi(g.y)); w.z = cvt_pk_bf16(v1[0] * bflo(g.z), v1[1] * bfhi(g.z)); w.w = cvt_pk_bf16(v1[2] * bflo(g.w), v1[3] * bfhi(g.w));
                    *(pg8::u32x4*)(merged + row * DM + col0 + bj * HALF) = w; } }
    }
};
struct EpiWo {
    static constexpr bool PERM = false;
    const float* x; float* y;
    __device__ __forceinline__ void operator()(const f32x4 (&acc)[2][2][4][2], const Unit& u, int wr, int wc, int fr, int fq) const {
        const int row0 = u.pm * BM + wr * 64 + fr, col0 = u.pn * BM + wc * 32 + 4 * fq;
#pragma unroll
        for (int ai = 0; ai < 2; ++ai)
#pragma unroll
            for (int m = 0; m < 4; ++m) { const size_t off = (size_t)(row0 + ai * HALF + m * 16) * DM + col0;
#pragma unroll
                for (int bj = 0; bj < 2; ++bj)
#pragma unroll
                    for (int n = 0; n < 2; ++n) { const f32x4 xv = *(const f32x4*)(x + off + bj * HALF + n * 16); *(f32x4*)(y + off + bj * HALF + n * 16) = xv * ALPHA + acc[ai][bj][m][n]; } }
    }
};
struct EpiGateUp {
    static constexpr bool PERM = true;
    bf16* H;
    __device__ __forceinline__ void operator()(const f32x4 (&acc)[2][2][4][2], const Unit& u, int wr, int wc, int fr, int fq) const {
        const int row0 = u.pm * BM + wr * 64 + fr, col0 = u.pn * HALF + wc * 32 + 8 * fq;
#pragma unroll
        for (int ai = 0; ai < 2; ++ai)
#pragma unroll
            for (int m = 0; m < 4; ++m) { bf16* rowp = H + (size_t)(row0 + ai * HALF + m * 16) * DEXP + col0;
                f32x4 h0, h1;
#pragma unroll
                for (int j = 0; j < 4; ++j) { const float a0 = acc[ai][0][m][0][j], a1 = acc[ai][0][m][1][j];
                    h0[j] = a0 * __builtin_amdgcn_rcpf(1.f + __builtin_amdgcn_exp2f(-1.4426950408889634f * a0)) * acc[ai][1][m][0][j];
                    h1[j] = a1 * __builtin_amdgcn_rcpf(1.f + __builtin_amdgcn_exp2f(-1.4426950408889634f * a1)) * acc[ai][1][m][1][j]; }
                pg8::u32x4 w; w.x = cvt_pk_bf16(h0[0], h0[1]); w.y = cvt_pk_bf16(h0[2], h0[3]); w.z = cvt_pk_bf16(h1[0], h1[1]); w.w = cvt_pk_bf16(h1[2], h1[3]);
                *(pg8::u32x4*)rowp = w; }
    }
};
struct EpiDown {
    static constexpr bool PERM = true;
    bf16* Y; const unsigned* list;
    __device__ __forceinline__ void operator()(const f32x4 (&acc)[2][2][4][2], const Unit& u, int wr, int wc, int fr, int fq) const {
        const int r0 = wr * 64 + fr, col0 = u.pn * BM + wc * 32 + 8 * fq;
#pragma unroll
        for (int ai = 0; ai < 2; ++ai)
#pragma unroll
            for (int m = 0; m < 4; ++m) { const int r = r0 + ai * HALF + m * 16;
                if (r < u.nv) { const unsigned li = list[u.aux + r]; const unsigned tok = li >> 1, k = li & 1u;
                    bf16* rowp = Y + ((size_t)k * MTOK + tok) * DM + col0;
#pragma unroll
                    for (int bj = 0; bj < 2; ++bj) { const f32x4 v0 = acc[ai][bj][m][0], v1 = acc[ai][bj][m][1];
                        pg8::u32x4 w; w.x = cvt_pk_bf16(v0[0], v0[1]); w.y = cvt_pk_bf16(v0[2], v0[3]); w.z = cvt_pk_bf16(v1[0], v1[1]); w.w = cvt_pk_bf16(v1[2], v1[3]);
                        *(pg8::u32x4*)(rowp + bj * HALF) = w; } } }
    }
};

struct MoeOrder {
    const LAS int* tab; const unsigned* list; int NT, G, c;
    __device__ __forceinline__ bool next(int i, Unit& u) const {
        const int T = __builtin_amdgcn_readfirstlane(tab[0]); const int L = i * G + c; if (L >= T * NT) return false;
        const int tile = L / NT, pn = L % NT; const int e = __builtin_amdgcn_readfirstlane(tab[64 + tile]); const int mt = tile - __builtin_amdgcn_readfirstlane(tab[1 + e]);
        u.pm = tile; u.pn = pn; u.pb = e * NT + pn; u.aux = e * MTOK + 256 * mt; u.nv = __builtin_amdgcn_readfirstlane(tab[256 + e]) - 256 * mt; return true;
    }
    __device__ __forceinline__ unsigned row_of(const Unit& u, int r) const { const int rr = r < u.nv ? r : u.nv - 1; return list[u.aux + rr] >> 1; }
    __device__ __forceinline__ void a_ready(const Unit&) const {}
    __device__ __forceinline__ void done(const Unit&) const {}
};
__device__ __forceinline__ void moe_plan(Frame& F) {
    LAS int* tab = (LAS int*)(F.lds + TAB_OFF);
    if (F.tid < NEXP) { int c = (int)__hip_atomic_load(F.ctl + CW_CNT + 64 * F.tid, RLX_AGENT); if (c > MTOK) c = MTOK; if (c < 0) c = 0; tab[256 + F.tid] = c; tab[320 + F.tid] = (c + 255) >> 8; }
    __syncthreads();
    if (F.tid == 0) { int s = 0; for (int e = 0; e < NEXP; ++e) { tab[1 + e] = s; s += tab[320 + e]; } if (s > HROWS / 256) s = HROWS / 256; tab[0] = s; }
    __syncthreads();
    if (F.tid < HROWS / 256) { int e = 0; for (int q = 0; q < NEXP; ++q) { if (F.tid >= tab[1 + q] && F.tid < tab[1 + q] + tab[320 + q]) e = q; } tab[64 + F.tid] = e; }
    __syncthreads();
}

typedef short s16x4 __attribute__((ext_vector_type(4)));
typedef short v4i16_t __attribute__((ext_vector_type(4)));
typedef short bf16x8v __attribute__((ext_vector_type(8)));
__device__ __forceinline__ s16x4 vtr(const LAS unsigned char* p) { return __builtin_bit_cast(s16x4, __builtin_amdgcn_ds_read_tr16_b64_v4i16((LAS v4i16_t*)p)); }
__device__ __forceinline__ bf16x8v cat8(s16x4 lo, s16x4 hi) { bf16x8v r; r[0] = lo[0]; r[1] = lo[1]; r[2] = lo[2]; r[3] = lo[3]; r[4] = hi[0]; r[5] = hi[1]; r[6] = hi[2]; r[7] = hi[3]; return r; }
__device__ __forceinline__ bf16x8v pack8(const f32x4& a, const f32x4& b) { v4u w; w.x = cvt_pk_bf16(a[0], a[1]); w.y = cvt_pk_bf16(a[2], a[3]); w.z = cvt_pk_bf16(b[0], b[1]); w.w = cvt_pk_bf16(b[2], b[3]); return __builtin_bit_cast(bf16x8v, w); }
constexpr float LOG2E = 1.4426950408889634f, LN2 = 0.6931471805599453f;

__device__ __forceinline__ void dil_unit(Frame& F, int g, int b, int h, int r, int n) {
    int tid = F.tid; asm volatile("" : "+v"(tid));
    const int lane = tid & 63, w = F.wave, l15 = lane & 15, gq = lane >> 4;
    const int d = g == 0 ? 1 : (g == 1 ? 4 : 16);
    const bf16* PA = (const bf16*)(F.ws + WS_PA);
    const size_t tok0 = (size_t)b * SEQ + r;
    LAS unsigned char* Kt = F.lds + RING_OFF; LAS unsigned char* Vt = F.lds + RING_OFF + 65536;
    const int colq = PA_Q + g * 512 + h * 128, colk = PA_K + g * 512 + h * 128, colv = PA_V + g * 512 + h * 128;
    { const int nrow0 = (n > 0) ? 0 : 128;
      const __amdgpu_buffer_rsrc_t rs = __builtin_amdgcn_make_buffer_rsrc((void*)(PA + (tok0 + (size_t)(128 * (n - 1) + nrow0) * d) * NA), (short)0, 0x7fffff00, 0x00020000);
      const int rstride = d * NA * 2; const int voff = (tid >> 4) * rstride + 16 * (tid & 15); const int r0 = tid >> 4, ch = tid & 15;
      LAS unsigned char* kw = Kt + r0 * 256 + ((ch ^ (r0 & 15)) << 4); LAS unsigned char* vw = Vt + r0 * 256 + ((ch ^ (2 * (r0 & 7))) << 4);
#pragma unroll
      for (int c = 0; c < 8; ++c) { v4u kv = (v4u){0u, 0u, 0u, 0u}, vv = (v4u){0u, 0u, 0u, 0u};
        if (n > 0 || c >= 4) { const int soff = (32 * c - nrow0) * rstride; kv = __builtin_amdgcn_raw_buffer_load_b128(rs, voff + colk * 2, soff, 0); vv = __builtin_amdgcn_raw_buffer_load_b128(rs, voff + colv * 2, soff, 0); }
        *(LAS v4u*)(kw + 8192 * c) = kv; *(LAS v4u*)(vw + 8192 * c) = vv; } }
    const int qi = 16 * w + l15; const size_t qtok = tok0 + (size_t)(128 * n + qi) * d;
    bf16x8v qf[4];
#pragma unroll
    for (int ks = 0; ks < 4; ++ks) qf[ks] = *(const bf16x8v*)(PA + qtok * NA + colq + 32 * ks + 8 * gq);
    __syncthreads();
    f32x4 st[10];
#pragma unroll
    for (int bi = 0; bi < 10; ++bi) { const int blk = (w + bi) < 15 ? (w + bi) : 15; const int row = 16 * blk + l15; f32x4 a = (f32x4){0.f, 0.f, 0.f, 0.f};
#pragma unroll
        for (int ks = 0; ks < 4; ++ks) { const bf16x8v kf = *(const LAS bf16x8v*)(Kt + row * 256 + (((4 * ks + gq) ^ l15) << 4)); a = __builtin_amdgcn_mfma_f32_16x16x32_bf16(kf, qf[ks], a, 0, 0, 0); }
        st[bi] = a; }
    const float slope = exp2f(-8.0f * (float)(g * 4 + h + 1) / 12.0f);
    const float c2 = slope * (float)d * LOG2E, sc2 = 0.08838834764831845f * LOG2E;
    float mx = -INFINITY;
#pragma unroll
    for (int bi = 0; bi < 10; ++bi)
#pragma unroll
        for (int q = 0; q < 4; ++q) { const int kj = 16 * (w + bi) + 4 * gq + q, jrel = qi + 128 - kj; const bool valid = (jrel >= 0) && (jrel <= 128) && (n > 0 || kj >= 128);
            const float s = valid ? st[bi][q] * sc2 - c2 * (float)jrel : -INFINITY; st[bi][q] = s; mx = fmaxf(mx, s); }
    mx = fmaxf(mx, __shfl_xor(mx, 16)); mx = fmaxf(mx, __shfl_xor(mx, 32));
    float lsum = 0.f;
#pragma unroll
    for (int bi = 0; bi < 10; ++bi)
#pragma unroll
        for (int q = 0; q < 4; ++q) { const float p = __builtin_amdgcn_exp2f(st[bi][q] - mx); st[bi][q] = p; lsum += p; }
    lsum += __shfl_xor(lsum, 16); lsum += __shfl_xor(lsum, 32);
    bf16x8v pf[5];
#pragma unroll
    for (int s = 0; s < 5; ++s) pf[s] = pack8(st[2 * s], st[2 * s + 1]);
    const float inv = 1.f / lsum;
    bf16* outp; int ldo;
    if (g == 0) { outp = (bf16*)(F.ws + WS_ACAT) + qtok * KCAT + 1024 + h * 128; ldo = KCAT; } else { outp = (bf16*)(F.ws + WS_DILO) + ((size_t)(g - 1) * MTOK + qtok) * DIL_OUT + h * 128; ldo = DIL_OUT; }
    (void)ldo;
    const int tq = l15 >> 2, tp = l15 & 3;
#pragma unroll 1
    for (int db = 0; db < 8; ++db) { f32x4 o = (f32x4){0.f, 0.f, 0.f, 0.f};
#pragma unroll
        for (int s = 0; s < 5; ++s) { const int b0 = (w + 2 * s) < 15 ? (w + 2 * s) : 15, b1 = (w + 2 * s + 1) < 15 ? (w + 2 * s + 1) : 15;
            const int r0 = 16 * b0 + 4 * gq + tq, r1 = 16 * b1 + 4 * gq + tq; const int sw = 2 * ((4 * gq + tq) & 7);
            const s16x4 lo = vtr(Vt + r0 * 256 + (((2 * db + (tp >> 1)) ^ sw) << 4) + 8 * (tp & 1)), hi = vtr(Vt + r1 * 256 + (((2 * db + (tp >> 1)) ^ sw) << 4) + 8 * (tp & 1));
            o = __builtin_amdgcn_mfma_f32_16x16x32_bf16(cat8(lo, hi), pf[s], o, 0, 0, 0); }
        v2u ov; ov.x = cvt_pk_bf16(o[0] * inv, o[1] * inv); ov.y = cvt_pk_bf16(o[2] * inv, o[3] * inv);
        *(v2u*)(outp + 16 * db + 4 * gq) = ov; }
    if (gq == 0) ((float*)(F.ws + WS_LSE))[((size_t)g * MTOK + qtok) * 4 + h] = (mx + __builtin_amdgcn_logf(lsum)) * LN2;
    __syncthreads();
}
__device__ __forceinline__ void mem_unit(Frame& F, int b, int h, int qb) {
    int tid = F.tid; asm volatile("" : "+v"(tid));
    const int lane = tid & 63, w = F.wave, l15 = lane & 15, gq = lane >> 4;
    const bf16* PA = (const bf16*)(F.ws + WS_PA); const bf16* MKV = (const bf16*)(F.ws + WS_MKV);
    LAS unsigned char* T = F.lds + RING_OFF;
    const bf16* kvb = MKV + (size_t)(b * MEM_LEN) * (2 * MEM_DIM) + h * 256;
    const __amdgpu_buffer_rsrc_t rs = __builtin_amdgcn_make_buffer_rsrc((void*)kvb, (short)0, 0x7fffff00, 0x00020000);
    const int r0 = tid >> 5, ch = tid & 31, voff = r0 * (2 * MEM_DIM * 2) + 16 * ch;
    { LAS unsigned char* kw = T + r0 * 512 + ((ch ^ (r0 & 15)) << 4);
#pragma unroll
      for (int c = 0; c < 16; ++c) { const v4u kv = __builtin_amdgcn_raw_buffer_load_b128(rs, voff, c * 16 * (2 * MEM_DIM * 2), 0); *(LAS v4u*)(kw + 8192 * c) = kv; } }
    const size_t qtok = (size_t)b * SEQ + 128 * qb + 16 * w + l15;
    bf16x8v qf[8];
#pragma unroll
    for (int ks = 0; ks < 8; ++ks) qf[ks] = *(const bf16x8v*)(PA + qtok * NA + PA_MQ + h * 256 + 32 * ks + 8 * gq);
    __syncthreads();
    f32x4 st[16];
#pragma unroll
    for (int bi = 0; bi < 16; ++bi) { const int row = 16 * bi + l15; f32x4 a = (f32x4){0.f, 0.f, 0.f, 0.f};
#pragma unroll
        for (int ks = 0; ks < 8; ++ks) { const bf16x8v kf = *(const LAS bf16x8v*)(T + row * 512 + (((4 * ks + gq) ^ l15) << 4)); a = __builtin_amdgcn_mfma_f32_16x16x32_bf16(kf, qf[ks], a, 0, 0, 0); }
        st[bi] = a; }
    const float sc2 = 0.0625f * LOG2E;
    float mx = -INFINITY;
#pragma unroll
    for (int bi = 0; bi < 16; ++bi)
#pragma unroll
        for (int q = 0; q < 4; ++q) { st[bi][q] *= sc2; mx = fmaxf(mx, st[bi][q]); }
    mx = fmaxf(mx, __shfl_xor(mx, 16)); mx = fmaxf(mx, __shfl_xor(mx, 32));
    float lsum = 0.f;
#pragma unroll
    for (int bi = 0; bi < 16; ++bi)
#pragma unroll
        for (int q = 0; q < 4; ++q) { const float p = __builtin_amdgcn_exp2f(st[bi][q] - mx); st[bi][q] = p; lsum += p; }
    lsum += __shfl_xor(lsum, 16); lsum += __shfl_xor(lsum, 32);
    bf16x8v pf[8];
#pragma unroll
    for (int s = 0; s < 8; ++s) pf[s] = pack8(st[2 * s], st[2 * s + 1]);
    const float inv = 1.f / lsum;
    __syncthreads();
    { LAS unsigned char* vw = T + r0 * 512 + ((ch ^ (2 * (r0 & 7))) << 4);
#pragma unroll
      for (int c = 0; c < 16; ++c) { const v4u vv = __builtin_amdgcn_raw_buffer_load_b128(rs, voff + MEM_DIM * 2, c * 16 * (2 * MEM_DIM * 2), 0); *(LAS v4u*)(vw + 8192 * c) = vv; } }
    __syncthreads();
    bf16* outp = (bf16*)(F.ws + WS_ACAT) + qtok * KCAT + 1536 + h * 256;
    const int tq = l15 >> 2, tp = l15 & 3;
#pragma unroll 1
    for (int db = 0; db < 16; ++db) { f32x4 o = (f32x4){0.f, 0.f, 0.f, 0.f};
#pragma unroll
        for (int s = 0; s < 8; ++s) { const int r0 = 32 * s + 4 * gq + tq, r1 = r0 + 16; const int sw = 2 * ((4 * gq + tq) & 7);
            const s16x4 lo = vtr(T + r0 * 512 + (((2 * db + (tp >> 1)) ^ sw) << 4) + 8 * (tp & 1)), hi = vtr(T + r1 * 512 + (((2 * db + (tp >> 1)) ^ sw) << 4) + 8 * (tp & 1));
            o = __builtin_amdgcn_mfma_f32_16x16x32_bf16(cat8(lo, hi), pf[s], o, 0, 0, 0); }
        v2u ov; ov.x = cvt_pk_bf16(o[0] * inv, o[1] * inv); ov.y = cvt_pk_bf16(o[2] * inv, o[3] * inv);
        *(v2u*)(outp + 16 * db + 4 * gq) = ov; }
    __syncthreads();
}
__device__ __forceinline__ void p2_attention(Frame& F) {
    const int c = F.vcu, G = F.G;
    for (int L = c; L < 2048; L += G) {
        if (L < 1536) { const int g = L >> 9, x = L & 511, b = x >> 6, h = (x >> 4) & 3;
            if (g == 0) dil_unit(F, 0, b, h, 0, x & 15); else if (g == 1) dil_unit(F, 1, b, h, (x >> 2) & 3, x & 3); else dil_unit(F, 2, b, h, x & 15, 0); }
        else { const int x = L - 1536; mem_unit(F, x >> 6, (x >> 4) & 3, x & 15); }
    }
}
__device__ __forceinline__ void p3_conv_combine(Frame& F) {
    const int gw = F.vcu * NWAVES + F.wave, NGW = F.G * NWAVES, lane = F.lane;
    const bf16* PA = (const bf16*)(F.ws + WS_PA); bf16* AC = (bf16*)(F.ws + WS_ACAT);
    { const float* wc = F.in[6];
      const size_t nitem = (size_t)MTOK * (CONV_DIM / 8);
      for (size_t it = (size_t)gw * 64 + lane; it < nitem; it += (size_t)NGW * 64) {
        const int tok = (int)(it / (CONV_DIM / 8)), c8 = (int)(it % (CONV_DIM / 8)) * 8, t = tok & (SEQ - 1);
        float accv[8];
#pragma unroll
        for (int j = 0; j < 8; ++j) accv[j] = 0.f;
#pragma unroll
        for (int d = 0; d < 3; ++d) { if (t - (2 - d) >= 0) { const bf16* rowp = PA + (size_t)(tok - (2 - d)) * NA;
            const v4u c4 = *(const v4u*)(rowp + PA_CC + c8), h4 = *(const v4u*)(rowp + PA_CH + c8);
            const unsigned cw[4] = {c4.x, c4.y, c4.z, c4.w}, hw[4] = {h4.x, h4.y, h4.z, h4.w};
#pragma unroll
            for (int q = 0; q < 4; ++q) { accv[2 * q] += wc[d * CONV_DIM + c8 + 2 * q] * (bflo(cw[q]) * bflo(hw[q])); accv[2 * q + 1] += wc[d * CONV_DIM + c8 + 2 * q + 1] * (bfhi(cw[q]) * bfhi(hw[q])); } } }
        const v4u b4 = *(const v4u*)(PA + (size_t)tok * NA + PA_CB + c8); const unsigned bw[4] = {b4.x, b4.y, b4.z, b4.w};
        v4u o; o.x = pk2(bflo(bw[0]) * accv[0], bfhi(bw[0]) * accv[1]); o.y = pk2(bflo(bw[1]) * accv[2], bfhi(bw[1]) * accv[3]); o.z = pk2(bflo(bw[2]) * accv[4], bfhi(bw[2]) * accv[5]); o.w = pk2(bflo(bw[3]) * accv[6], bfhi(bw[3]) * accv[7]);
        *(v4u*)(AC + (size_t)tok * KCAT + c8) = o; } }
    { const bf16* DO = (const bf16*)(F.ws + WS_DILO); const float* LSE = (const float*)(F.ws + WS_LSE);
      const size_t nitem = (size_t)MTOK * (DIL_OUT / 8);
      for (size_t it = (size_t)gw * 64 + lane; it < nitem; it += (size_t)NGW * 64) {
        const size_t tok = it / (DIL_OUT / 8); const int c8 = (int)(it % (DIL_OUT / 8)) * 8, h = c8 >> 7;
        const float l0 = LSE[tok * 4 + h], l1 = LSE[((size_t)MTOK + tok) * 4 + h], l2 = LSE[((size_t)2 * MTOK + tok) * 4 + h];
        const float m = fmaxf(l0, fmaxf(l1, l2)); float w0 = __expf(l0 - m), w1 = __expf(l1 - m), w2 = __expf(l2 - m); const float iw = 1.f / (w0 + w1 + w2); w0 *= iw; w1 *= iw; w2 *= iw;
        bf16* op = AC + tok * KCAT + 1024 + c8;
        const v4u a = *(const v4u*)op, bb = *(const v4u*)(DO + tok * DIL_OUT + c8), cc = *(const v4u*)(DO + ((size_t)MTOK + tok) * DIL_OUT + c8);
        const unsigned aw[4] = {a.x, a.y, a.z, a.w}, bw[4] = {bb.x, bb.y, bb.z, bb.w}, cw[4] = {cc.x, cc.y, cc.z, cc.w}; unsigned ow[4];
#pragma unroll
        for (int q = 0; q < 4; ++q) ow[q] = pk2(w0 * bflo(aw[q]) + w1 * bflo(bw[q]) + w2 * bflo(cw[q]), w0 * bfhi(aw[q]) + w1 * bfhi(bw[q]) + w2 * bfhi(cw[q]));
        *(v4u*)op = (v4u){ow[0], ow[1], ow[2], ow[3]}; } }
}

__device__ __forceinline__ void p5_ln_route(Frame& F) {
    const int gw = F.vcu * NWAVES + F.wave, NGW = F.G * NWAVES, lane = F.lane;
    float* Y1 = F.out; bf16* X1B = (bf16*)(F.ws + WS_X1B); unsigned* list = (unsigned*)(F.ws + WS_LIST); float* tokw = (float*)(F.ws + WS_TOKW);
    const float* g1 = F.in[12]; const float* b1 = F.in[13]; const float* wg = F.in[14]; const float* bg = F.in[15]; const float* wrt = F.in[16]; const float* brt = F.in[17];
    for (int m = gw; m < MTOK; m += NGW) {
        GAS f32x4* xr = (GAS f32x4*)(Y1 + (size_t)m * DM) + lane; f32x4 v[8]; float s = 0.f;
#pragma unroll
        for (int j = 0; j < 8; ++j) { v[j] = xr[64 * j]; s += (v[j].x + v[j].y) + (v[j].z + v[j].w); }
        const float mean = wave_sum(s) * (1.f / DM); float s2 = 0.f;
#pragma unroll
        for (int j = 0; j < 8; ++j) { v[j] = v[j] - mean; s2 += (v[j].x * v[j].x + v[j].y * v[j].y) + (v[j].z * v[j].z + v[j].w * v[j].w); }
        const float rstd = 1.f / sqrtf(wave_sum(s2) * (1.f / DM) + LN_EPS);
        GAS v2u* o8 = (GAS v2u*)(X1B + (size_t)m * DM) + lane;
        float gl[4] = {0.f, 0.f, 0.f, 0.f};
#pragma unroll
        for (int j = 0; j < 8; ++j) { const f32x4 gg = ((const GAS f32x4*)g1)[lane + 64 * j], bb = ((const GAS f32x4*)b1)[lane + 64 * j]; v[j] = v[j] * rstd * gg + bb;
            xr[64 * j] = v[j]; v2u o; o.x = pk2(v[j].x, v[j].y); o.y = pk2(v[j].z, v[j].w); o8[64 * j] = o;
            const GAS f32x4* wp = (const GAS f32x4*)wg + 4 * (lane + 64 * j);
#pragma unroll
            for (int q = 0; q < 4; ++q) { const f32x4 w = wp[q]; const float xv = v[j][q]; gl[0] += xv * w.x; gl[1] += xv * w.y; gl[2] += xv * w.z; gl[3] += xv * w.w; } }
#pragma unroll
        for (int g = 0; g < 4; ++g) gl[g] = wave_sum(gl[g]) + bg[g];
        int gsel = 0; float gmax = gl[0];
#pragma unroll
        for (int g = 1; g < 4; ++g) if (gl[g] > gmax) { gmax = gl[g]; gsel = g; }
        float gden = 0.f;
#pragma unroll
        for (int g = 0; g < 4; ++g) gden += __expf(gl[g] - gmax);
        const float gwt = 1.f / gden;
        gsel = __builtin_amdgcn_readfirstlane(gsel);
        float el[8] = {0.f, 0.f, 0.f, 0.f, 0.f, 0.f, 0.f, 0.f};
        const GAS f32x4* wr4 = (const GAS f32x4*)(wrt + (size_t)gsel * DM * 8);
#pragma unroll
        for (int j = 0; j < 8; ++j)
#pragma unroll
            for (int q = 0; q < 4; ++q) { const int d = 4 * (lane + 64 * j) + q; const f32x4 wa = wr4[2 * d], wb = wr4[2 * d + 1]; const float xv = v[j][q];
                el[0] += xv * wa.x; el[1] += xv * wa.y; el[2] += xv * wa.z; el[3] += xv * wa.w; el[4] += xv * wb.x; el[5] += xv * wb.y; el[6] += xv * wb.z; el[7] += xv * wb.w; }
#pragma unroll
        for (int e = 0; e < 8; ++e) el[e] = wave_sum(el[e]) + brt[gsel * 8 + e];
        int i1 = 0; float v1 = el[0];
#pragma unroll
        for (int e = 1; e < 8; ++e) if (el[e] > v1) { v1 = el[e]; i1 = e; }
        int i2 = -1; float v2 = -INFINITY;
#pragma unroll
        for (int e = 0; e < 8; ++e) if (e != i1 && el[e] > v2) { v2 = el[e]; i2 = e; }
        const float e2 = __expf(v2 - v1), w1 = gwt / (1.f + e2), w2 = gwt * e2 / (1.f + e2);
        if (lane < 2) { const int ex = gsel * 8 + (lane == 0 ? i1 : i2); const unsigned slot = __hip_atomic_fetch_add(F.ctl + CW_CNT + 64 * ex, 1u, RLX_AGENT);
            if (slot < (unsigned)MTOK) list[(size_t)ex * MTOK + slot] = (unsigned)m * 2u + (unsigned)lane;
            tokw[2 * m + lane] = lane == 0 ? w1 : w2; }
    }
    LAS float* scr = (LAS float*)(F.lds + RING_OFF + F.wave * 16384);
    bf16* WGU = (bf16*)(F.ws + WS_WGU); bf16* WD = (bf16*)(F.ws + WS_WD);
    constexpr int IGU = (DM / 64) * (DEXP / 32), IDN = (DEXP / 64) * (DM / 32), IPE = 2 * IGU + IDN;
    for (int it = gw; it < NEXP * IPE; it += NGW) {
        const int e = it / IPE; int r = it % IPE;
        if (r < 2 * IGU) { const int up = r >= IGU; if (up) r -= IGU; const int nblk = DEXP / 32, kb = r / nblk, nb = r % nblk, n0 = 32 * nb;
            const float* W = (up ? F.in[19] : F.in[18]) + (size_t)e * DM * DEXP;
            transpose_item(W, DEXP, WGU, DM, (size_t)e * 1024 + 256 * (n0 >> 7) + (n0 & 127) + (up ? 128 : 0), 64 * kb, 64 * kb, n0, scr, lane); }
        else { r -= 2 * IGU; const int nblk = DM / 32, kb = r / nblk, nb = r % nblk;
            transpose_item(F.in[20] + (size_t)e * DEXP * DM, DM, WD, DEXP, (size_t)e * DM + 32 * nb, 64 * kb, 64 * kb, 32 * nb, scr, lane); }
    }
}

__device__ __forceinline__ void p8_final(Frame& F) {
    const int gw = F.vcu * NWAVES + F.wave, NGW = F.G * NWAVES, lane = F.lane;
    float* X1 = F.out; const bf16* Y = (const bf16*)(F.ws + WS_Y); const float* tokw = (const float*)(F.ws + WS_TOKW); const float* g2 = F.in[21]; const float* b2 = F.in[22];
    for (int m = gw; m < MTOK; m += NGW) {
        GAS f32x4* xr = (GAS f32x4*)(X1 + (size_t)m * DM) + lane; const GAS v2u* y0 = (const GAS v2u*)(Y + (size_t)m * DM) + lane; const GAS v2u* y1 = (const GAS v2u*)(Y + ((size_t)MTOK + m) * DM) + lane;
        const float w0 = tokw[2 * m], w1 = tokw[2 * m + 1];
        f32x4 v[8]; float s = 0.f;
#pragma unroll
        for (int j = 0; j < 8; ++j) { const f32x4 x = xr[64 * j]; const v2u a = y0[64 * j], b = y1[64 * j];
            f32x4 ya; ya.x = bflo(a.x); ya.y = bfhi(a.x); ya.z = bflo(a.y); ya.w = bfhi(a.y); f32x4 yb; yb.x = bflo(b.x); yb.y = bfhi(b.x); yb.z = bflo(b.y); yb.w = bfhi(b.y);
            v[j] = x * ALPHA + ya * w0 + yb * w1; s += (v[j].x + v[j].y) + (v[j].z + v[j].w); }
        const float mean = wave_sum(s) * (1.f / DM); float s2 = 0.f;
#pragma unroll
        for (int j = 0; j < 8; ++j) { v[j] = v[j] - mean; s2 += (v[j].x * v[j].x + v[j].y * v[j].y) + (v[j].z * v[j].z + v[j].w * v[j].w); }
        const float rstd = 1.f / sqrtf(wave_sum(s2) * (1.f / DM) + LN_EPS);
#pragma unroll
        for (int j = 0; j < 8; ++j) { const f32x4 gg = ((const GAS f32x4*)g2)[lane + 64 * j], bb = ((const GAS f32x4*)b2)[lane + 64 * j]; xr[64 * j] = v[j] * rstd * gg + bb; }
    }
}

struct Args { const float* in[23]; float* out; unsigned char* ws; int ph_lo, ph_hi, li, pad; };
__global__ void __launch_bounds__(NWAVES * 64, 2) fwd(Args args) {
    extern __shared__ __attribute__((aligned(16))) unsigned char lds[];
    Frame F;
    F.lds = (LAS unsigned char*)lds;
    F.MISC = (volatile LAS unsigned*)(F.lds + MISC_OFF);
    F.tid = threadIdx.x; F.lane = F.tid & 63; F.wave = __builtin_amdgcn_readfirstlane(F.tid >> 6);
    F.G = gridDim.x; { const int bx = blockIdx.x; F.vcu = (F.G % 8 == 0) ? (bx % 8) * (F.G / 8) + bx / 8 : bx; }
    F.ws = args.ws; F.ctl = (gu32*)(args.ws + WS_CTL); F.out = args.out;
#pragma unroll
    for (int i = 0; i < 23; ++i) F.in[i] = args.in[i];
    for (int u = F.tid; u < (LDS_BYTES - LDSCTL_OFF) / 4; u += NWAVES * 64) ((LAS unsigned*)(F.lds + LDSCTL_OFF))[u] = 0u;
    __syncthreads();
    XcdBarrier bar; bar.bar = (unsigned*)(F.ctl + CW_BAR); bar.x = 0; bar.st = nullptr;
    if (N_LAUNCHES == 1) bar = xcd_barrier_post((unsigned*)(F.ctl + CW_BAR), F.MISC + 8);
#define GRID_BAR() do { if (N_LAUNCHES == 1) xcd_barrier(bar); } while (0)
    const int lo = args.ph_lo, hi = args.ph_hi;
#define IN(k) (lo <= (k) && (k) < hi)
#define BOTH(k) (IN(k) && IN((k) + 1))
    unsigned char* ws = args.ws;
    const int bx = (int)blockIdx.x;

    if (IN(0)) { p0_prologue(F); if (REP0 > 1) p0_prologue(F); if (BOTH(0)) GRID_BAR(); }

    if (IN(1)) {
        { pg8::Gemm g{(const bf16*)(ws + WS_XB), (const bf16*)(ws + WS_WIN), DM, DM, DM}; pg8::StaticOrder S; S.init(MTOK, IN_DIM, F.G, bx);
          EpiProj E{(bf16*)(ws + WS_PA), (bf16*)(ws + WS_GATES), F.in[5]};
          pg8::gemm_phase<EpiProj, pg8::StaticOrder, true, false>(F.lds + RING_OFF, g, S, E); }
        if (REP1 > 1)
        { pg8::Gemm g{(const bf16*)(ws + WS_XB), (const bf16*)(ws + WS_WIN), DM, DM, DM}; pg8::StaticOrder S; S.init(MTOK, IN_DIM, F.G, bx);
          EpiProj E{(bf16*)(ws + WS_PA), (bf16*)(ws + WS_GATES), F.in[5]};
          pg8::gemm_phase<EpiProj, pg8::StaticOrder, true, false>(F.lds + RING_OFF, g, S, E); }
        { pg8::Gemm g{(const bf16*)(ws + WS_MEMN), (const bf16*)(ws + WS_WKV), DM, DM, DM}; pg8::StaticOrder S; S.init(BATCH * MEM_LEN, 2 * MEM_DIM, F.G, (bx + F.G / 2) % F.G);
          EpiPlain E{(bf16*)(ws + WS_MKV), 2 * MEM_DIM};
          pg8::gemm_phase<EpiPlain, pg8::StaticOrder, true, false>(F.lds + RING_OFF, g, S, E); }
        if (BOTH(1)) GRID_BAR();
    }

    if (IN(2)) { p2_attention(F); if (REP2 > 1) p2_attention(F); if (BOTH(2)) GRID_BAR(); }

    if (IN(3)) { p3_conv_combine(F); if (BOTH(3)) GRID_BAR(); }

    if (IN(4)) {
        pg8::Gemm g{(const bf16*)(ws + WS_ACAT), (const bf16*)(ws + WS_WCAT), KCAT, KCAT, KCAT}; pg8::StaticOrder S; S.init(MTOK, DM, F.G, bx);
        EpiMerged E{(const bf16*)(ws + WS_GATES), (bf16*)(ws + WS_MERGED)};
        pg8::gemm_phase<EpiMerged, pg8::StaticOrder, true, false, true>(F.lds + RING_OFF, g, S, E);
        if (REP4 > 1) { pg8::gemm_phase<EpiMerged, pg8::StaticOrder, true, false, true>(F.lds + RING_OFF, g, S, E); }
        if (BOTH(4)) GRID_BAR();
    }

    if (IN(5)) {
        pg8::Gemm g{(const bf16*)(ws + WS_MERGED), (const bf16*)(ws + WS_WO), DM, DM, DM}; pg8::StaticOrder S; S.init(MTOK, DM, F.G, bx);
        EpiWo E{F.in[0], F.out};
        pg8::gemm_phase<EpiWo, pg8::StaticOrder, true, false>(F.lds + RING_OFF, g, S, E);
        if (REP5 > 1) { pg8::gemm_phase<EpiWo, pg8::StaticOrder, true, false>(F.lds + RING_OFF, g, S, E); }
        if (BOTH(5)) GRID_BAR();
    }

    if (IN(6)) { p5_ln_route(F); if (BOTH(6)) GRID_BAR(); }

    if (IN(7)) {
        moe_plan(F);
        pg8::Gemm g{(const bf16*)(ws + WS_X1B), (const bf16*)(ws + WS_WGU), DM, DM, DM};
        MoeOrder S{(const LAS int*)(F.lds + TAB_OFF), (const unsigned*)(ws + WS_LIST), 4, F.G, bx};
        EpiGateUp E{(bf16*)(ws + WS_H)};
        pg8::gemm_phase<EpiGateUp, MoeOrder, true, true>(F.lds + RING_OFF, g, S, E);
        if (REP7 > 1) { pg8::gemm_phase<EpiGateUp, MoeOrder, true, true>(F.lds + RING_OFF, g, S, E); }
        if (BOTH(7)) GRID_BAR();
    }

    if (IN(8)) {
        moe_plan(F);
        pg8::Gemm g{(const bf16*)(ws + WS_H), (const bf16*)(ws + WS_WD), DEXP, DEXP, DEXP};
        MoeOrder S{(const LAS int*)(F.lds + TAB_OFF), (const unsigned*)(ws + WS_LIST), 8, F.G, bx};
        EpiDown E{(bf16*)(ws + WS_Y), (const unsigned*)(ws + WS_LIST)};
        pg8::gemm_phase<EpiDown, MoeOrder, true, false>(F.lds + RING_OFF, g, S, E);
        if (REP8 > 1) { pg8::gemm_phase<EpiDown, MoeOrder, true, false>(F.lds + RING_OFF, g, S, E); }
        if (BOTH(8)) GRID_BAR();
    }

    if (IN(9)) { p8_final(F); }
#undef IN
#undef BOTH
#undef GRID_BAR
}

extern "C" void kernel_launch(void* const* d_in, const int* in_sizes, int n_in, void* d_out, int out_size, void* d_ws, size_t ws_size, hipStream_t stream) {
    static int grid = 0;
    if (grid == 0) {
        if (n_in != 23 || in_sizes[0] != MTOK * DM || out_size != MTOK * DM || ws_size < WS_END) { fprintf(stderr, "kernel_launch: unexpected shapes/workspace (n_in %d, ws %zu); nothing launched\n", n_in, ws_size); grid = -1; return; }
        int dev = 0, cus = 0, per_cu = 0;
        if (hipGetDevice(&dev) != hipSuccess || hipDeviceGetAttribute(&cus, hipDeviceAttributeMultiprocessorCount, dev) != hipSuccess) { grid = -1; return; }
        if (hipFuncSetAttribute((const void*)fwd, hipFuncAttributeMaxDynamicSharedMemorySize, LDS_BYTES) != hipSuccess) { fprintf(stderr, "kernel_launch: hipFuncSetAttribute failed\n"); grid = -1; return; }
        if (hipOccupancyMaxActiveBlocksPerMultiprocessor(&per_cu, (const void*)fwd, NWAVES * 64, LDS_BYTES) != hipSuccess || per_cu < 1) fprintf(stderr, "kernel_launch: occupancy query reports %d\n", per_cu);
        (void)hipGetLastError();
        grid = cus;
    }
    if (grid < 0) return;
    if (hipMemsetAsync((char*)d_ws + WS_CTL, 0, CTL_ZERO_BYTES, stream) != hipSuccess) return;
    Args a{};
    for (int i = 0; i < 23; ++i) a.in[i] = (const float*)d_in[i];
    a.out = (float*)d_out; a.ws = (unsigned char*)d_ws;
    for (int li = 0; li < N_LAUNCHES; ++li) {
        a.ph_lo = (N_LAUNCHES == 1) ? 0 : li; a.ph_hi = (N_LAUNCHES == 1) ? N_PHASES : li + 1; a.li = li;
        hipLaunchKernelGGL(fwd, dim3(grid), dim3(NWAVES * 64), LDS_BYTES, stream, a);
        if (hipPeekAtLastError() != hipSuccess) { fprintf(stderr, "kernel_launch: launch %d failed\n", li); break; }
    }
}
```
